# Optimizing an MI355X kernel written in HIP

```python
import math
import jax, jax.numpy as jnp
from jax import lax
import numpy as np

D_MODEL = 2048
BATCH = 2
SEQ = 4096
DEPTH = 1

MEM_LEN = 256
MIX_A_WIDTH = D_MODEL // 2
MIX_B_WIDTH = D_MODEL - MIX_A_WIDTH
A_GROUPS = 8
A_HEAD = MIX_A_WIDTH // A_GROUPS
A_CHUNK = 128
B_HEAD_K = 128
B_HEAD_V = 128
B_HEADS = MIX_B_WIDTH // B_HEAD_V
B_CHUNK = 64
XA_HEADS = 4
XA_HEAD = D_MODEL // XA_HEADS
PEER_HEADS = 8
PEER_NKEYS = 128
PEER_EXPERTS = PEER_NKEYS * PEER_NKEYS
PEER_QDIM = 256
PEER_HALF = PEER_QDIM // 2
PEER_TOPK = 16
PEER_TOKEN_BLOCK = 128
LN_EPS = 1e-5
DN_ALPHA = (2.0 * DEPTH) ** 0.25
DN_BETA = (8.0 * DEPTH) ** -0.25
IN_COLS = 2 * MIX_A_WIDTH + 4 * MIX_B_WIDTH
SPLITS = [MIX_A_WIDTH, 2 * MIX_A_WIDTH, 2 * MIX_A_WIDTH + MIX_B_WIDTH,
          2 * MIX_A_WIDTH + 2 * MIX_B_WIDTH, 2 * MIX_A_WIDTH + 3 * MIX_B_WIDTH]

kernel_name = 'hybrid_sgu_hgrn2_peer_deepnorm'


def layer_norm(x, g, b):
    xf = x.astype(jnp.float32)
    mu = jnp.mean(xf, axis=-1, keepdims=True)
    var = jnp.mean(jnp.square(xf - mu), axis=-1, keepdims=True)
    return ((xf - mu) * lax.rsqrt(var + LN_EPS) * g + b).astype(x.dtype)


def rms_norm(x, g):
    xf = x.astype(jnp.float32)
    return xf * lax.rsqrt(jnp.mean(jnp.square(xf), axis=-1, keepdims=True) + LN_EPS) * g


def chunked_sgu(u, v, w_s, b_s, vg, vb):
    B_, S_, _ = u.shape
    nc = S_ // A_CHUNK
    u = jax.nn.gelu(u)
    v = jax.nn.gelu(v).reshape(B_, S_, A_GROUPS, A_HEAD)
    v = layer_norm(v, vg, vb).reshape(B_, nc, A_CHUNK, A_GROUPS, A_HEAD)
    causal = jnp.tril(jnp.ones((A_CHUNK, A_CHUNK), dtype=bool))
    w = jnp.where(causal, w_s, 0.0)
    z = jnp.einsum('gts,bcsgd->bctgd', w, v) + b_s.T[None, None, :, :, None]
    return u * z.reshape(B_, S_, MIX_A_WIDTH)


def hgrn2(q, f_logit, i, g, lb, gn):
    B_, S_, _ = q.shape
    nc = S_ // B_CHUNK
    f32 = jnp.float32
    lbf = lb.astype(f32)
    f = lbf + (1.0 - lbf) * jax.nn.sigmoid(f_logit.astype(f32))
    log_f = jnp.log(f)
    k = 1.0 - f

    def to_chunks(t, d):
        return t.reshape(B_, nc, B_CHUNK, B_HEADS, d).transpose(1, 0, 3, 2, 4)

    qc = to_chunks(q.astype(f32), B_HEAD_K)
    kc = to_chunks(k, B_HEAD_K)
    lc = to_chunks(log_f, B_HEAD_K)
    ic = to_chunks(i.astype(f32), B_HEAD_V)
    causal = jnp.tril(jnp.ones((B_CHUNK, B_CHUNK), dtype=bool))[:, :, None]

    def step(state, xs):
        qb, kb, lfb, ib = xs
        a = jnp.cumsum(lfb, axis=2)
        a_last = a[:, :, -1, :]
        diff = a[:, :, :, None, :] - a[:, :, None, :, :]
        decay = jnp.exp(jnp.where(causal, diff, -jnp.inf))
        scores = jnp.einsum('bhtk,bhsk,bhtsk->bhts', qb, kb, decay)
        o = (jnp.einsum('bhts,bhsv->bhtv', scores, ib)
             + jnp.einsum('bhtk,bhkv->bhtv', qb * jnp.exp(a), state))
        new_state = (jnp.exp(a_last)[..., None] * state
                     + jnp.einsum('bhsk,bhsv->bhkv', kb * jnp.exp(a_last[:, :, None, :] - a), ib))
        return new_state, o

    s0 = jnp.zeros((B_, B_HEADS, B_HEAD_K, B_HEAD_V), f32)
    _, oc = lax.scan(step, s0, (qc, kc, lc, ic))
    o = oc.transpose(1, 0, 3, 2, 4).reshape(B_, S_, B_HEADS, B_HEAD_V)
    o = rms_norm(o, gn).reshape(B_, S_, MIX_B_WIDTH) * jax.nn.silu(g.astype(f32))
    return o.astype(q.dtype)


def memory_cross_attention(x, mem, wq, wk, wv, wo):
    B_, S_, _ = x.shape
    M_ = mem.shape[1]
    q = (x @ wq).reshape(B_, S_, XA_HEADS, XA_HEAD)
    k = (mem @ wk).reshape(B_, M_, XA_HEADS, XA_HEAD)
    v = (mem @ wv).reshape(B_, M_, XA_HEADS, XA_HEAD)
    s = jnp.einsum('bshd,bmhd->bhsm', q, k).astype(jnp.float32) * (1.0 / math.sqrt(XA_HEAD))
    p = jax.nn.softmax(s, axis=-1).astype(v.dtype)
    o = jnp.einsum('bhsm,bmhd->bshd', p, v).reshape(B_, S_, D_MODEL)
    return o @ wo


def peer(x, wq, sub_k1, sub_k2, u_tab, v_tab):
    B_, S_, _ = x.shape
    f32 = jnp.float32
    q = (x @ wq).astype(f32).reshape(B_, S_, PEER_HEADS, 2, PEER_HALF)
    s1 = jnp.einsum('bshd,nd->bshn', q[..., 0, :], sub_k1.astype(f32))
    s2 = jnp.einsum('bshd,nd->bshn', q[..., 1, :], sub_k2.astype(f32))
    v1, i1 = lax.top_k(s1, PEER_TOPK)
    v2, i2 = lax.top_k(s2, PEER_TOPK)
    cand = (v1[..., :, None] + v2[..., None, :]).reshape(B_, S_, PEER_HEADS, PEER_TOPK * PEER_TOPK)
    cand_idx = (i1[..., :, None] * PEER_NKEYS + i2[..., None, :]).reshape(B_, S_, PEER_HEADS, PEER_TOPK * PEER_TOPK)
    top_s, top_pos = lax.top_k(cand, PEER_TOPK)
    experts = jnp.take_along_axis(cand_idx, top_pos, axis=-1)
    gates = jax.nn.softmax(top_s, axis=-1).astype(x.dtype)
    nb = (B_ * S_) // PEER_TOKEN_BLOCK
    xb = x.reshape(nb, PEER_TOKEN_BLOCK, D_MODEL)
    eb = experts.reshape(nb, PEER_TOKEN_BLOCK, PEER_HEADS, PEER_TOPK)
    gb = gates.reshape(nb, PEER_TOKEN_BLOCK, PEER_HEADS, PEER_TOPK)

    def block(args):
        xt, et, gt = args
        u = u_tab[et]
        h = jax.nn.gelu(jnp.einsum('td,thkd->thk', xt, u))
        return jnp.einsum('thk,thkd->td', gt * h, v_tab[et])

    out = lax.map(block, (xb, eb, gb))
    return out.reshape(B_, S_, D_MODEL)


def setup_inputs(seed: int = 0) -> dict:
    key = jax.random.key(seed)
    ks = jax.random.split(key, 32)
    n = jax.random.normal
    L = DEPTH
    D = D_MODEL
    return {
        'x': n(ks[0], (BATCH, SEQ, D), jnp.float32),
        'mem': n(ks[1], (BATCH, MEM_LEN, D), jnp.float32),
        'w_in': n(ks[2], (L, D, IN_COLS), jnp.float32) * D ** -0.5,
        'sgu_w': n(ks[3], (L, A_GROUPS, A_CHUNK, A_CHUNK), jnp.float32) * A_CHUNK ** -0.5,
        'sgu_b': 1.0 + 0.02 * n(ks[4], (L, A_GROUPS, A_CHUNK), jnp.float32),
        'sgu_ln_g': 1.0 + 0.02 * n(ks[5], (L, A_GROUPS, A_HEAD), jnp.float32),
        'sgu_ln_b': 0.02 * n(ks[6], (L, A_GROUPS, A_HEAD), jnp.float32),
        'hgrn_lb_logits': 0.5 * n(ks[7], (L + 1, B_HEADS * B_HEAD_K), jnp.float32),
        'hgrn_norm_g': 1.0 + 0.02 * n(ks[8], (L, B_HEADS, B_HEAD_V), jnp.float32),
        'w_out': n(ks[9], (L, D, D), jnp.float32) * D ** -0.5 * DN_BETA,
        'ln1_g': 1.0 + 0.02 * n(ks[10], (L, D), jnp.float32),
        'ln1_b': 0.02 * n(ks[11], (L, D), jnp.float32),
        'xa_wq': n(ks[12], (L, D, D), jnp.float32) * D ** -0.5,
        'xa_wk': n(ks[13], (L, D, D), jnp.float32) * D ** -0.5,
        'xa_wv': n(ks[14], (L, D, D), jnp.float32) * D ** -0.5 * DN_BETA,
        'xa_wo': n(ks[15], (L, D, D), jnp.float32) * D ** -0.5 * DN_BETA,
        'ln2_g': 1.0 + 0.02 * n(ks[16], (L, D), jnp.float32),
        'ln2_b': 0.02 * n(ks[17], (L, D), jnp.float32),
        'peer_wq': n(ks[18], (L, D, PEER_HEADS * PEER_QDIM), jnp.float32) * D ** -0.5,
        'peer_k1': n(ks[19], (L, PEER_NKEYS, PEER_HALF), jnp.float32) * PEER_HALF ** -0.5,
        'peer_k2': n(ks[20], (L, PEER_NKEYS, PEER_HALF), jnp.float32) * PEER_HALF ** -0.5,
        'peer_u': n(ks[21], (L, PEER_EXPERTS, D), jnp.float32) * D ** -0.5,
        'peer_v': n(ks[22], (L, PEER_EXPERTS, D), jnp.float32) * DN_BETA * PEER_HEADS ** -0.5,
        'ln3_g': 1.0 + 0.02 * n(ks[23], (L, D), jnp.float32),
        'ln3_b': 0.02 * n(ks[24], (L, D), jnp.float32),
    }


def reference(x, mem, w_in, sgu_w, sgu_b, sgu_ln_g, sgu_ln_b, hgrn_lb_logits, hgrn_norm_g,
              w_out, ln1_g, ln1_b, xa_wq, xa_wk, xa_wv, xa_wo, ln2_g, ln2_b,
              peer_wq, peer_k1, peer_k2, peer_u, peer_v, ln3_g, ln3_b):
    lb_all = jnp.cumsum(jax.nn.softmax(hgrn_lb_logits.astype(jnp.float32), axis=0), axis=0)
    for l in range(DEPTH):
        h = x @ w_in[l]
        ua, va, qb, fb, ib, gb = jnp.split(h, SPLITS, axis=-1)
        ya = chunked_sgu(ua, va, sgu_w[l], sgu_b[l], sgu_ln_g[l], sgu_ln_b[l])
        yb = hgrn2(qb, fb, ib, gb, lb_all[l], hgrn_norm_g[l])
        mix = jnp.concatenate([ya, yb.astype(ya.dtype)], axis=-1) @ w_out[l]
        x = layer_norm(DN_ALPHA * x + mix, ln1_g[l], ln1_b[l])
        xa = memory_cross_attention(x, mem, xa_wq[l], xa_wk[l], xa_wv[l], xa_wo[l])
        x = layer_norm(DN_ALPHA * x + xa, ln2_g[l], ln2_b[l])
        ff = peer(x, peer_wq[l], peer_k1[l], peer_k2[l], peer_u[l], peer_v[l])
        x = layer_norm(DN_ALPHA * x + ff, ln3_g[l], ln3_b[l])
    return x
```

```cpp
#include <hip/hip_runtime.h>
#include <stdint.h>
#include <stdio.h>

#ifndef ONE_LAUNCH
#define ONE_LAUNCH 1
#endif

typedef unsigned short u16;
using bf16x8 = __attribute__((ext_vector_type(8))) short;
using f32x16 = __attribute__((ext_vector_type(16))) float;
using f32x2 = __attribute__((ext_vector_type(2))) float;
using f32x4 = __attribute__((ext_vector_type(4))) float;
using u32x4 = __attribute__((ext_vector_type(4))) unsigned int;

#define NTOK 8192
#define DM 2048
#define SEQ 4096
#define NPHASE 13
#define LN_EPS 1e-5f
#define DN_ALPHA 1.189207115002721f

constexpr size_t SZ_DD = (size_t)2048 * 2048 * 2;
constexpr size_t OFF_WT_IN = 0;
constexpr size_t OFF_WT_OUT = OFF_WT_IN + (size_t)6144 * 2048 * 2;
constexpr size_t OFF_WQ_B = OFF_WT_OUT + SZ_DD;
constexpr size_t OFF_WT_K = OFF_WQ_B + SZ_DD;
constexpr size_t OFF_WT_V = OFF_WT_K + SZ_DD;
constexpr size_t OFF_WT_O = OFF_WT_V + SZ_DD;
constexpr size_t OFF_PWQ_B = OFF_WT_O + SZ_DD;
constexpr size_t OFF_WQKT = OFF_PWQ_B + SZ_DD;
constexpr size_t OFF_WVOT = OFF_WQKT + SZ_DD;
constexpr size_t OFF_WSKT = OFF_WVOT + SZ_DD;
constexpr size_t OFF_MEMB = OFF_WSKT + SZ_DD;
constexpr size_t OFF_KP = OFF_MEMB + (size_t)512 * 2048 * 2;
constexpr size_t OFF_VP = OFF_KP + (size_t)512 * 2048 * 2;
constexpr size_t OFF_K1B = OFF_VP + (size_t)512 * 2048 * 2;
constexpr size_t OFF_K2B = OFF_K1B + 32768;
constexpr size_t OFF_DEC = OFF_K2B + 32768;
constexpr size_t OFF_BAR = OFF_DEC + (size_t)1024 * 128 * 4;
constexpr size_t OFF_RC = OFF_BAR + 16384;
constexpr size_t OFF_RD = OFF_RC + (size_t)NTOK * DM * 2;
constexpr size_t OFF_RE = OFF_RD + (size_t)NTOK * DM * 4;
constexpr size_t OFF_RA = OFF_RE + (size_t)NTOK * DM * 4;
constexpr size_t SZ_SEG = (size_t)NTOK * 1024 * 2;
constexpr size_t OFF_UA = OFF_RA;
constexpr size_t OFF_VA = OFF_UA + SZ_SEG;
constexpr size_t OFF_QB = OFF_VA + SZ_SEG;
constexpr size_t OFF_IB = OFF_QB + SZ_SEG;
constexpr size_t OFF_GB = OFF_IB + SZ_SEG;
constexpr size_t OFF_LF = OFF_GB + SZ_SEG;
constexpr size_t OFF_RB = OFF_LF + (size_t)NTOK * 1024 * 4;
constexpr size_t OFF_UT = OFF_RB;
constexpr size_t OFF_ST = OFF_UT + (size_t)1024 * 16384 * 4;
constexpr size_t OFF_END = OFF_ST + (size_t)1024 * 16384 * 2;
constexpr size_t OFF_UB = OFF_RA;
constexpr size_t OFF_VB = OFF_UB + (size_t)16384 * 2048;
constexpr size_t OFF_SU = OFF_VB + (size_t)16384 * 2048;
constexpr size_t OFF_SV = OFF_SU + 65536;
constexpr size_t OFF_SC = OFF_RB + (size_t)48 * 1048576;
constexpr size_t OFF_PB = OFF_RB + (size_t)80 * 1048576;
static_assert(OFF_SV + 65536 <= OFF_SC, "alias overlap");
static_assert(OFF_PB + (size_t)NTOK * 1024 * 2 <= OFF_END, "alias overflow");

#define SMEM_BYTES 74240

struct Params {
    const float* x; const float* mem; const float* w_in; const float* sgu_w; const float* sgu_b;
    const float* sgu_ln_g; const float* sgu_ln_b; const float* lb_logits; const float* hgrn_g;
    const float* w_out; const float* ln1_g; const float* ln1_b; const float* xa_wq; const float* xa_wk;
    const float* xa_wv; const float* xa_wo; const float* ln2_g; const float* ln2_b; const float* peer_wq;
    const float* peer_k1; const float* peer_k2; const float* peer_u; const float* peer_v;
    const float* ln3_g; const float* ln3_b;
    float* out; unsigned char* ws;
    int ph_lo; int ph_hi;
};

typedef __bf16 bf16x2_t __attribute__((ext_vector_type(2)));
__device__ __forceinline__ u16 f2bf(float f) { return __builtin_bit_cast(u16, (__bf16)f); }
__device__ __forceinline__ float bf2f(u16 h) { return __uint_as_float(((uint32_t)h) << 16); }
__device__ __forceinline__ uint32_t pack2(float a, float b) {
    f32x2 v = {a, b};
    return __builtin_bit_cast(uint32_t, __builtin_convertvector(v, bf16x2_t));
}
__device__ __forceinline__ void st_bf4(u16* p, f32x4 v) { *(uint2*)p = make_uint2(pack2(v[0], v[1]), pack2(v[2], v[3])); }
__device__ __forceinline__ float bflo(uint32_t w) { return __uint_as_float(w << 16); }
__device__ __forceinline__ float bfhi(uint32_t w) { return __uint_as_float(w & 0xffff0000u); }
__device__ __forceinline__ float gelu_t(float x) {
    float u = 0.7978845608028654f * (x + 0.044715f * x * x * x);
    return x * __builtin_amdgcn_rcpf(1.f + __expf(-2.f * u));
}
__device__ __forceinline__ float sigmoid_f(float x) { return __builtin_amdgcn_rcpf(1.f + __expf(-x)); }
__device__ __forceinline__ unsigned sort_key(float v) {
    const unsigned b = __float_as_uint(v);
    return (b & 0x80000000u) ? ~b : (b | 0x80000000u);
}
__device__ __forceinline__ float wsum(float v) {
#pragma unroll
    for (int o = 32; o > 0; o >>= 1) v += __shfl_xor(v, o);
    return v;
}

__device__ __forceinline__ int opaque_tid() { int t = threadIdx.x; asm volatile("" : "+v"(t)); return t; }

#define XB_TMO      128
#define XB_XCNT(j)  (256  + 64 * (j))
#define XB_XSUB(j)  (1280 + 64 * (j))
#define XB_XGEN(j)  (2304 + 64 * (j))
#define XB_TOP      3328
#define XB_TOPGEN   3392
#define XCD_BAR_WORDS 3456
#define XB_SPIN_CAP (1u << 22)
#define LAS __attribute__((address_space(3)))
__device__ __forceinline__ unsigned xb_ld(unsigned* p) { return __hip_atomic_load(p, __ATOMIC_RELAXED, __HIP_MEMORY_SCOPE_AGENT); }
__device__ __forceinline__ unsigned xb_add(unsigned* p, unsigned v) { return __hip_atomic_fetch_add(p, v, __ATOMIC_RELAXED, __HIP_MEMORY_SCOPE_AGENT); }
__device__ __forceinline__ unsigned xb_xcc_id() { return (unsigned)__builtin_amdgcn_s_getreg((3 << 11) | 20) & 0xFu; }
#define XB_SPIN(cond, bar) do { unsigned _sp = 0; while (cond) { __builtin_amdgcn_s_sleep(1); \
    if ((++_sp & 255u) == 0u) { if (xb_ld(&(bar)[XB_TMO])) break; if (_sp > XB_SPIN_CAP) { atomicAdd(&(bar)[XB_TMO], 1u); break; } } } } while (0)
struct XcdBarrier { unsigned* bar; unsigned x; volatile LAS unsigned* st; };
__device__ __forceinline__ XcdBarrier xcd_barrier_post(unsigned* bar, volatile LAS unsigned* st) {
    XcdBarrier b; b.bar = bar; b.x = xb_xcc_id(); b.st = st;
    if (threadIdx.x == 0) st[2] = xb_add(&bar[XB_XCNT(b.x)], 1u);
    return b;
}
__device__ __forceinline__ void xcd_barrier_complete(unsigned* bar, unsigned x, unsigned& nloc, unsigned& nx) {
    const unsigned G = gridDim.x * gridDim.y * gridDim.z;
    unsigned sum, cnt, mine, sp = 0u;
    for (;;) {
        sum = 0u; cnt = 0u; mine = 0u;
#pragma unroll
        for (unsigned j = 0; j < 16; ++j) { const unsigned c = xb_ld(&bar[XB_XCNT(j)]); sum += c; cnt += (c > 0u) ? 1u : 0u; mine = (j == x) ? c : mine; }
        if (sum == G) break;
        __builtin_amdgcn_s_sleep(1);
        if ((++sp & 255u) == 0u) { if (xb_ld(&bar[XB_TMO])) break; if (sp > XB_SPIN_CAP) { atomicAdd(&bar[XB_TMO], 1u); break; } }
    }
    nloc = mine > 0u ? mine : 1u; nx = cnt > 0u ? cnt : 1u;
}
__device__ __forceinline__ void xcd_barrier(const XcdBarrier& b) {
    asm volatile("s_waitcnt vmcnt(0)" ::: "memory");
    __syncthreads();
    if (threadIdx.x == 0) {
        unsigned* bar = b.bar;
        __builtin_amdgcn_s_waitcnt(0);
        unsigned nloc = b.st[0], nx = b.st[1];
        if (nloc == 0u) { xcd_barrier_complete(bar, b.x, nloc, nx); b.st[0] = nloc; b.st[1] = nx; }
        const unsigned old = xb_add(&bar[XB_XSUB(b.x)], 1u);
        const unsigned gen = old / nloc;
        if (old + 1u == (gen + 1u) * nloc) {
            __builtin_amdgcn_fence(__ATOMIC_RELEASE, "agent");
            asm volatile("s_waitcnt vmcnt(0)" ::: "memory");
            const unsigned og = xb_add(&bar[XB_TOP], 1u);
            const unsigned tg = og / nx;
            if (og + 1u == (tg + 1u) * nx) xb_add(&bar[XB_TOPGEN], 1u);
            else XB_SPIN(xb_ld(&bar[XB_TOPGEN]) == tg, bar);
            __builtin_amdgcn_fence(__ATOMIC_ACQUIRE, "agent");
            xb_add(&bar[XB_XGEN(b.x)], 1u);
            asm volatile("s_waitcnt vmcnt(0)" ::: "memory");
        } else {
            XB_SPIN(xb_ld(&bar[XB_XGEN(b.x)]) == gen, bar);
            __builtin_amdgcn_fence(__ATOMIC_ACQUIRE, "agent");
            asm volatile("s_waitcnt vmcnt(0)" ::: "memory");
        }
    }
    __syncthreads();
}

template <class Epi>
__device__ __forceinline__ void gemm_tile(const u16* __restrict__ A, int lda, const u16* __restrict__ Bt, int ldb, int K,
                                          unsigned char* smem, Epi epi) {
    const int tid = opaque_tid(), lane = tid & 63, wave = tid >> 6;
    const int wm = wave >> 1, wn = wave & 1;
    f32x16 acc[2][2];
#pragma unroll
    for (int i = 0; i < 2; ++i)
#pragma unroll
        for (int j = 0; j < 2; ++j)
#pragma unroll
            for (int r = 0; r < 16; ++r) acc[i][j][r] = 0.f;
    const int lr = wave * 32 + (lane >> 3);
    const int lc = lane & 7;
    const u16* gA[4]; const u16* gB[4];
#pragma unroll
    for (int i = 0; i < 4; ++i) {
        const int row = lr + 8 * i;
        const int ch = lc ^ ((row >> 1) & 7);
        gA[i] = A + (size_t)row * lda + ch * 8;
        gB[i] = Bt + (size_t)row * ldb + ch * 8;
    }
    unsigned char* sbase = smem + wave * 4096;
    auto glds = [&](int k0, int buf) {
        unsigned char* dA = sbase + buf * 32768;
        unsigned char* dB = dA + 16384;
#pragma unroll
        for (int i = 0; i < 4; ++i) {
            __builtin_amdgcn_global_load_lds((const unsigned*)(gA[i] + k0), (__attribute__((address_space(3))) unsigned*)(dA + i * 1024), 16, 0, 0);
            __builtin_amdgcn_global_load_lds((const unsigned*)(gB[i] + k0), (__attribute__((address_space(3))) unsigned*)(dB + i * 1024), 16, 0, 0);
        }
    };
    int offA[2], offB[2], swA[2], swB[2];
#pragma unroll
    for (int i = 0; i < 2; ++i) {
        const int ra = wm * 64 + i * 32 + (lane & 31), rb = wn * 64 + i * 32 + (lane & 31);
        offA[i] = ra * 128; swA[i] = (ra >> 1) & 7;
        offB[i] = rb * 128; swB[i] = (rb >> 1) & 7;
    }
    const int half = lane >> 5;
    __syncthreads();
    glds(0, 0);
    asm volatile("s_waitcnt vmcnt(0)" ::: "memory");
    __syncthreads();
    const int nk = K >> 6;
    for (int kt = 0; kt < nk; ++kt) {
        const int buf = kt & 1;
        const int kn = ((kt + 1 < nk) ? (kt + 1) : kt) * 64;
        unsigned char* dA = sbase + (buf ^ 1) * 32768;
        unsigned char* dB = dA + 16384;
        const unsigned char* bA = smem + buf * 32768;
        const unsigned char* bB = bA + 16384;
#pragma unroll
        for (int ks = 0; ks < 4; ++ks) {
            bf16x8 af[2], bf[2];
            const int kc = ks * 2 + half;
#pragma unroll
            for (int i = 0; i < 2; ++i) af[i] = *(const bf16x8*)(bA + offA[i] + ((kc ^ swA[i]) << 4));
#pragma unroll
            for (int j = 0; j < 2; ++j) bf[j] = *(const bf16x8*)(bB + offB[j] + ((kc ^ swB[j]) << 4));
#pragma unroll
            for (int i = 0; i < 2; ++i)
#pragma unroll
                for (int j = 0; j < 2; ++j)
                    acc[i][j] = __builtin_amdgcn_mfma_f32_32x32x16_bf16(bf[j], af[i], acc[i][j], 0, 0, 0);
            __builtin_amdgcn_global_load_lds((const unsigned*)(gA[ks] + kn), (__attribute__((address_space(3))) unsigned*)(dA + ks * 1024), 16, 0, 0);
            __builtin_amdgcn_global_load_lds((const unsigned*)(gB[ks] + kn), (__attribute__((address_space(3))) unsigned*)(dB + ks * 1024), 16, 0, 0);
        }
        asm volatile("s_waitcnt vmcnt(0)" ::: "memory");
        __syncthreads();
    }
#pragma unroll
    for (int i = 0; i < 2; ++i)
#pragma unroll
        for (int j = 0; j < 2; ++j)
#pragma unroll
            for (int g = 0; g < 4; ++g) {
                const int row = wm * 64 + i * 32 + (lane & 31);
                const int col = wn * 64 + j * 32 + 8 * g + 4 * (lane >> 5);
                const f32x4 v = {acc[i][j][4 * g], acc[i][j][4 * g + 1], acc[i][j][4 * g + 2], acc[i][j][4 * g + 3]};
                epi(row, col, v);
            }
}

#define FOR_TILES_XCD(NT, m, n)                                                                   \
    for (int _t = (int)(vbid >> 3), _x = (int)(vbid & 7), _np = (int)(gridDim.x >> 3), \
             m = 0, n = 0;                                                                         \
         (_t < 8 * (NT)) && ((m = 8 * _x + ((_t & 63) >> 3)), (n = ((_t >> 6) << 3) + (_t & 7)), true); _t += _np)

template <class Epi>
__device__ __forceinline__ void gemm_tile_big(const u16* __restrict__ A, int lda, const u16* __restrict__ Bt, int ldb, int K,
                                              unsigned char* smem, Epi epi, const float* __restrict__ res = nullptr, int ldres = 0, float alpha = 0.f) {
    const int tid = opaque_tid(), lane = tid & 63, wave = tid >> 6;
    const int wm = wave >> 1, wn = wave & 1;
    f32x16 acc[4][2];
    if (res) {
#pragma unroll
        for (int i = 0; i < 4; ++i)
#pragma unroll
            for (int j = 0; j < 2; ++j)
#pragma unroll
                for (int g = 0; g < 4; ++g) {
                    const int row = wm * 128 + i * 32 + (lane & 31);
                    const int col = wn * 64 + j * 32 + 8 * g + 4 * (lane >> 5);
                    const f32x4 x = *(const f32x4*)(res + (size_t)row * ldres + col);
                    acc[i][j][4 * g] = alpha * x[0]; acc[i][j][4 * g + 1] = alpha * x[1];
                    acc[i][j][4 * g + 2] = alpha * x[2]; acc[i][j][4 * g + 3] = alpha * x[3];
                }
    } else {
#pragma unroll
        for (int i = 0; i < 4; ++i)
#pragma unroll
            for (int j = 0; j < 2; ++j)
#pragma unroll
                for (int r = 0; r < 16; ++r) acc[i][j][r] = 0.f;
    }
    const u16* gA[4]; const u16* gB[2];
#pragma unroll
    for (int i = 0; i < 4; ++i) {
        const int row = wave * 64 + i * 16 + (lane >> 2);
        gA[i] = A + (size_t)row * lda + (((lane & 3) ^ ((row >> 2) & 3)) << 3);
    }
#pragma unroll
    for (int i = 0; i < 2; ++i) {
        const int row = wave * 32 + i * 16 + (lane >> 2);
        gB[i] = Bt + (size_t)row * ldb + (((lane & 3) ^ ((row >> 2) & 3)) << 3);
    }
    auto glds = [&](int k0, int st) {
        unsigned char* dA = smem + st * 24576 + wave * 4096;
        unsigned char* dB = smem + st * 24576 + 16384 + wave * 2048;
#pragma unroll
        for (int i = 0; i < 4; ++i)
            __builtin_amdgcn_global_load_lds((const unsigned*)(gA[i] + k0), (__attribute__((address_space(3))) unsigned*)(dA + i * 1024), 16, 0, 0);
#pragma unroll
        for (int i = 0; i < 2; ++i)
            __builtin_amdgcn_global_load_lds((const unsigned*)(gB[i] + k0), (__attribute__((address_space(3))) unsigned*)(dB + i * 1024), 16, 0, 0);
    };
    int offA[4], swA[4], offB[2], swB[2];
#pragma unroll
    for (int i = 0; i < 4; ++i) { const int ra = wm * 128 + i * 32 + (lane & 31); offA[i] = ra * 64; swA[i] = (ra >> 2) & 3; }
#pragma unroll
    for (int j = 0; j < 2; ++j) { const int rb = wn * 64 + j * 32 + (lane & 31); offB[j] = 16384 + rb * 64; swB[j] = (rb >> 2) & 3; }
    const int half = lane >> 5;
    const int nk = K >> 5;
    __syncthreads();
    glds(0, 0);
    glds(32, 1);
    int st = 0;
    for (int kt = 0; kt < nk; ++kt) {
        asm volatile("s_waitcnt vmcnt(6)\n\ts_waitcnt lgkmcnt(0)" ::: "memory");
        __builtin_amdgcn_s_barrier();
        const int kn = ((kt + 2 < nk) ? (kt + 2) : (nk - 1)) * 32;
        const int sn = (st >= 1) ? (st - 1) : 2;
        unsigned char* dA = smem + sn * 24576 + wave * 4096;
        unsigned char* dB = smem + sn * 24576 + 16384 + wave * 2048;
        const unsigned char* bS = smem + st * 24576;
#pragma unroll
        for (int ks = 0; ks < 2; ++ks) {
            bf16x8 af[4], bf[2];
            const int kc = ks * 2 + half;
#pragma unroll
            for (int i = 0; i < 4; ++i) af[i] = *(const bf16x8*)(bS + offA[i] + ((kc ^ swA[i]) << 4));
#pragma unroll
            for (int j = 0; j < 2; ++j) bf[j] = *(const bf16x8*)(bS + offB[j] + ((kc ^ swB[j]) << 4));
#pragma unroll
            for (int i = 0; i < 4; ++i)
#pragma unroll
                for (int j = 0; j < 2; ++j)
                    acc[i][j] = __builtin_amdgcn_mfma_f32_32x32x16_bf16(bf[j], af[i], acc[i][j], 0, 0, 0);
            if (ks == 0) {
#pragma unroll
                for (int i = 0; i < 3; ++i)
                    __builtin_amdgcn_global_load_lds((const unsigned*)(gA[i] + kn), (__attribute__((address_space(3))) unsigned*)(dA + i * 1024), 16, 0, 0);
            } else {
                __builtin_amdgcn_global_load_lds((const unsigned*)(gA[3] + kn), (__attribute__((address_space(3))) unsigned*)(dA + 3 * 1024), 16, 0, 0);
#pragma unroll
                for (int i = 0; i < 2; ++i)
                    __builtin_amdgcn_global_load_lds((const unsigned*)(gB[i] + kn), (__attribute__((address_space(3))) unsigned*)(dB + i * 1024), 16, 0, 0);
            }
        }
        st = (st == 2) ? 0 : (st + 1);
    }
    asm volatile("s_waitcnt vmcnt(0)" ::: "memory");
#pragma unroll
    for (int i = 0; i < 4; ++i)
#pragma unroll
        for (int j = 0; j < 2; ++j)
#pragma unroll
            for (int g = 0; g < 4; ++g) {
                const int row = wm * 128 + i * 32 + (lane & 31);
                const int col = wn * 64 + j * 32 + 8 * g + 4 * (lane >> 5);
                const f32x4 v = {acc[i][j][4 * g], acc[i][j][4 * g + 1], acc[i][j][4 * g + 2], acc[i][j][4 * g + 3]};
                epi(row, col, v);
            }
}
#define FOR_TILES_XCD_BIG(NT, m, n)                                                               \
    for (int _t = (int)(vbid >> 3), _x = (int)(vbid & 7), _np = (int)(gridDim.x >> 3), \
             m = 0, n = 0;                                                                         \
         (_t < 4 * (NT)) && ((m = 4 * _x + ((_t & 31) >> 3)), (n = ((_t >> 5) << 3) + (_t & 7)), true); _t += _np)


__device__ __forceinline__ bf16x8 ld_frag_strided(const u16* p, int stride) {
    bf16x8 f;
#pragma unroll
    for (int j = 0; j < 8; ++j) f[j] = (short)p[j * stride];
    return f;
}

__device__ __forceinline__ void cvt_job(const float* __restrict__ src, u16* __restrict__ dst, size_t n, int bid, int nb) {
    const size_t nchunk = n / 8;
    const int tid = opaque_tid();
    const size_t S = (size_t)nb * 256;
    for (size_t c = (size_t)bid * 256 + tid; c < nchunk; c += 4 * S) {
        f32x4 a[4], b[4];
#pragma unroll
        for (int u = 0; u < 4; ++u) {
            const size_t cc = c + u * S;
            if (cc < nchunk) { a[u] = *(const f32x4*)(src + cc * 8); b[u] = *(const f32x4*)(src + cc * 8 + 4); }
        }
#pragma unroll
        for (int u = 0; u < 4; ++u) {
            const size_t cc = c + u * S;
            if (cc < nchunk) {
                u32x4 o;
                o[0] = pack2(a[u][0], a[u][1]); o[1] = pack2(a[u][2], a[u][3]); o[2] = pack2(b[u][0], b[u][1]); o[3] = pack2(b[u][2], b[u][3]);
                *(u32x4*)(dst + cc * 8) = o;
            }
        }
    }
}
__device__ __forceinline__ void cvt_fp8_rows(const float* __restrict__ src, unsigned char* __restrict__ dst, float* __restrict__ scl, int row_begin, int row_end) {
    const int tid = opaque_tid(); const int lane = tid & 63, wave = tid >> 6;
    for (int row0 = row_begin + wave * 2; row0 < row_end; row0 += 8) {
        float4 v[2][8];
#pragma unroll
        for (int rr = 0; rr < 2; ++rr)
#pragma unroll
            for (int q = 0; q < 2; ++q)
#pragma unroll
                for (int i = 0; i < 4; ++i)
                    v[rr][q * 4 + i] = *(const float4*)(src + (size_t)(row0 + rr) * 2048 + q * 1024 + lane * 16 + i * 4);
#pragma unroll
        for (int rr = 0; rr < 2; ++rr) {
            const int row = row0 + rr;
            float am = 0.f;
#pragma unroll
            for (int i = 0; i < 8; ++i)
                am = fmaxf(am, fmaxf(fmaxf(fabsf(v[rr][i].x), fabsf(v[rr][i].y)), fmaxf(fabsf(v[rr][i].z), fabsf(v[rr][i].w))));
#pragma unroll
            for (int o = 32; o > 0; o >>= 1) am = fmaxf(am, __shfl_xor(am, o));
            const float sc = am > 0.f ? 240.f / am : 1.f;
            if (lane == 0) scl[row] = am > 0.f ? am * (1.f / 240.f) : 1.f;
#pragma unroll
            for (int q = 0; q < 2; ++q) {
                u32x4 o;
#pragma unroll
                for (int i = 0; i < 4; ++i) {
                    int w = 0;
                    w = __builtin_amdgcn_cvt_pk_fp8_f32(v[rr][q * 4 + i].x * sc, v[rr][q * 4 + i].y * sc, w, false);
                    w = __builtin_amdgcn_cvt_pk_fp8_f32(v[rr][q * 4 + i].z * sc, v[rr][q * 4 + i].w * sc, w, true);
                    o[i] = (unsigned)w;
                }
                *(u32x4*)(dst + (size_t)row * 2048 + q * 1024 + lane * 16) = o;
            }
        }
    }
}
__device__ __forceinline__ void transpose_job(const float* __restrict__ W, u16* __restrict__ Wt, int Kd, int Nd, unsigned char* smem, int bid, int nb) {
    float* t = (float*)smem;
    const int tid = opaque_tid();
    const int tk = Kd / 64, tn = Nd / 64, nt = tk * tn;
    const int lk = tid >> 4, n4 = (tid & 15) * 4;
    f32x4 v[2][4];
#pragma unroll
    for (int u = 0; u < 2; ++u) {
        const int tile = bid + u * nb;
        if (tile < nt) {
            const int k0 = (tile / tn) * 64, n0 = (tile % tn) * 64;
#pragma unroll
            for (int i = 0; i < 4; ++i) v[u][i] = *(const f32x4*)(W + (size_t)(k0 + lk + 16 * i) * Nd + n0 + n4);
        }
    }
    for (int tile0 = bid; tile0 < nt; tile0 += 2 * nb) {
        __syncthreads();
#pragma unroll
        for (int u = 0; u < 2; ++u)
#pragma unroll
            for (int i = 0; i < 4; ++i) {
                float* tp = t + u * (64 * 65) + (lk + 16 * i) * 65 + n4;
                tp[0] = v[u][i][0]; tp[1] = v[u][i][1]; tp[2] = v[u][i][2]; tp[3] = v[u][i][3];
            }
        __syncthreads();
#pragma unroll
        for (int u = 0; u < 2; ++u) {
            const int nxt = tile0 + (2 + u) * nb;
            if (nxt < nt) {
                const int k1 = (nxt / tn) * 64, n1 = (nxt % tn) * 64;
#pragma unroll
                for (int i = 0; i < 4; ++i) v[u][i] = *(const f32x4*)(W + (size_t)(k1 + lk + 16 * i) * Nd + n1 + n4);
            }
        }
#pragma unroll
        for (int u = 0; u < 2; ++u) {
            const int tile = tile0 + u * nb;
            if (tile < nt) {
                const int k0 = (tile / tn) * 64, n0 = (tile % tn) * 64;
                const float* tb = t + u * (64 * 65);
                const int n = tid >> 2, kq = (tid & 3) * 16;
                uint32_t o[8];
#pragma unroll
                for (int j = 0; j < 8; ++j) o[j] = pack2(tb[(kq + 2 * j) * 65 + n], tb[(kq + 2 * j + 1) * 65 + n]);
                u32x4* dp = (u32x4*)(Wt + (size_t)(n0 + n) * Kd + k0 + kq);
                dp[0] = u32x4{o[0], o[1], o[2], o[3]};
                dp[1] = u32x4{o[4], o[5], o[6], o[7]};
            }
        }
    }
}

__device__ __forceinline__ void ln_rows(const float* __restrict__ in, const float* __restrict__ g, const float* __restrict__ b,
                        float* __restrict__ of, u16* __restrict__ ob) {
    const int tid = opaque_tid(); const int lane = tid & 63, wave = tid >> 6;
    float4 gv[8], bv[8];
#pragma unroll
    for (int i = 0; i < 8; ++i) { gv[i] = *(const float4*)(g + i * 256 + lane * 4); bv[i] = *(const float4*)(b + i * 256 + lane * 4); }
    const int stride = gridDim.x * 4;
    int row = blockIdx.x * 4 + wave;
    float4 v[8];
    if (row < NTOK) {
#pragma unroll
        for (int i = 0; i < 8; ++i) v[i] = *(const float4*)(in + (size_t)row * DM + i * 256 + lane * 4);
    }
    for (; row < NTOK; row += stride) {
        float s = 0.f;
#pragma unroll
        for (int i = 0; i < 8; ++i) s += v[i].x + v[i].y + v[i].z + v[i].w;
        const float mu = wsum(s) * (1.f / DM);
        float q = 0.f;
#pragma unroll
        for (int i = 0; i < 8; ++i) {
            const float a = v[i].x - mu, bb = v[i].y - mu, c = v[i].z - mu, d = v[i].w - mu;
            q += a * a + bb * bb + c * c + d * d;
        }
        const float rs = rsqrtf(wsum(q) * (1.f / DM) + LN_EPS);
        float4 o[8];
#pragma unroll
        for (int i = 0; i < 8; ++i) {
            o[i].x = (v[i].x - mu) * rs * gv[i].x + bv[i].x; o[i].y = (v[i].y - mu) * rs * gv[i].y + bv[i].y;
            o[i].z = (v[i].z - mu) * rs * gv[i].z + bv[i].z; o[i].w = (v[i].w - mu) * rs * gv[i].w + bv[i].w;
        }
        const int nrow = row + stride;
        if (nrow < NTOK) {
#pragma unroll
            for (int i = 0; i < 8; ++i) v[i] = *(const float4*)(in + (size_t)nrow * DM + i * 256 + lane * 4);
        }
#pragma unroll
        for (int i = 0; i < 8; ++i) {
            const int c0 = i * 256 + lane * 4;
            *(float4*)(of + (size_t)row * DM + c0) = o[i];
            *(uint2*)(ob + (size_t)row * DM + c0) = make_uint2(pack2(o[i].x, o[i].y), pack2(o[i].z, o[i].w));
        }
    }
}

__device__ __forceinline__ void phase0(const Params& p, unsigned char* smem) {
    unsigned char* ws = p.ws;
    const int bid = blockIdx.x, nb = gridDim.x;
    cvt_job(p.x, (u16*)(ws + OFF_RC), (size_t)NTOK * DM, bid, nb);
    cvt_job(p.mem, (u16*)(ws + OFF_MEMB), (size_t)512 * DM, bid, nb);
    transpose_job(p.w_in, (u16*)(ws + OFF_WT_IN), 2048, 6144, smem, bid, nb);
    transpose_job(p.xa_wk, (u16*)(ws + OFF_WT_K), 2048, 2048, smem, bid, nb);
    transpose_job(p.xa_wv, (u16*)(ws + OFF_WT_V), 2048, 2048, smem, bid, nb);
}
__device__ __forceinline__ void phase0_deferred(const Params& p, unsigned char* smem, int bid, int nb) {
    unsigned char* ws = p.ws;
    cvt_job(p.xa_wq, (u16*)(ws + OFF_WQ_B), (size_t)DM * DM, bid, nb);
    cvt_job(p.peer_wq, (u16*)(ws + OFF_PWQ_B), (size_t)DM * DM, bid, nb);
    cvt_job(p.peer_k1, (u16*)(ws + OFF_K1B), (size_t)128 * 128, bid, nb);
    cvt_job(p.peer_k2, (u16*)(ws + OFF_K2B), (size_t)128 * 128, bid, nb);
    transpose_job(p.w_out, (u16*)(ws + OFF_WT_OUT), 2048, 2048, smem, bid, nb);
    transpose_job(p.xa_wo, (u16*)(ws + OFF_WT_O), 2048, 2048, smem, bid, nb);
}

__device__ __forceinline__ void phase1(const Params& p, unsigned char* smem, const int vbid) {
    unsigned char* ws = p.ws;
    const u16* xb = (const u16*)(ws + OFF_RC);
    FOR_TILES_XCD_BIG(48, m, n) {
        {
            const int seg = n >> 3;
            const int cb = (n & 7) * 128;
            const u16* A = xb + (size_t)m * 256 * DM;
            const u16* Bt = (const u16*)(ws + OFF_WT_IN) + (size_t)n * 128 * DM;
            const size_t rbase = (size_t)m * 256;
            if (seg == 3) {
                float* LF = (float*)(ws + OFF_LF);
                float* lbs = (float*)(smem + 73728);
                __syncthreads();
                {
                    const int t2 = opaque_tid();
                    if (t2 < 128) lbs[t2] = sigmoid_f(p.lb_logits[cb + t2] - p.lb_logits[1024 + cb + t2]);
                }
                gemm_tile_big(A, DM, Bt, DM, DM, smem, [&](int r, int c, f32x4 v) {
                    const f32x4 lb4 = *(const f32x4*)(lbs + c);
                    f32x4 o;
#pragma unroll
                    for (int q = 0; q < 4; ++q) o[q] = __logf(lb4[q] + (1.f - lb4[q]) * sigmoid_f(v[q]));
                    *(f32x4*)(LF + (rbase + r) * 1024 + cb + c) = o;
                });
            } else {
                u16* O = (u16*)(ws + (seg == 0 ? OFF_UA : seg == 1 ? OFF_VA : seg == 2 ? OFF_QB : seg == 4 ? OFF_IB : OFF_GB));
                if (seg <= 1) {
                    gemm_tile_big(A, DM, Bt, DM, DM, smem, [&](int r, int c, f32x4 v) { st_bf4(O + (rbase + r) * 1024 + cb + c, f32x4{gelu_t(v[0]), gelu_t(v[1]), gelu_t(v[2]), gelu_t(v[3])}); });
                } else if (seg == 5) {
                    gemm_tile_big(A, DM, Bt, DM, DM, smem, [&](int r, int c, f32x4 v) { st_bf4(O + (rbase + r) * 1024 + cb + c, f32x4{v[0] * sigmoid_f(v[0]), v[1] * sigmoid_f(v[1]), v[2] * sigmoid_f(v[2]), v[3] * sigmoid_f(v[3])}); });
                } else {
                    gemm_tile_big(A, DM, Bt, DM, DM, smem, [&](int r, int c, f32x4 v) { st_bf4(O + (rbase + r) * 1024 + cb + c, v); });
                }
            }
        }
    }
    if ((int)gridDim.x > 128) {
        if ((int)blockIdx.x >= 128) phase0_deferred(p, smem, (int)blockIdx.x - 128, (int)gridDim.x - 128);
    } else {
        phase0_deferred(p, smem, (int)blockIdx.x, (int)gridDim.x);
    }
    for (int idx = blockIdx.x; idx < 128; idx += gridDim.x) {
        {
            const int which = idx >> 6, m = (idx & 63) >> 4, n = idx & 15;
            const u16* A = (const u16*)(ws + OFF_MEMB) + (size_t)m * 128 * DM;
            const u16* Bt = (const u16*)(ws + (which ? OFF_WT_V : OFF_WT_K)) + (size_t)n * 128 * DM;
            u16* O = (u16*)(ws + (which ? OFF_VP : OFF_KP));
            gemm_tile(A, DM, Bt, DM, DM, smem, [&](int r, int c, f32x4 v) { st_bf4(O + (size_t)(m * 128 + r) * DM + n * 128 + c, v); });
        }
    }
}

__device__ __forceinline__ void sgu_item(const Params& p, int idx, unsigned char* smem) {
    unsigned char* ws = p.ws;
    const int b = idx >> 8, c = (idx >> 3) & 31, g = idx & 7;
    const size_t p0 = (size_t)b * SEQ + (size_t)c * 128;
    u16* sW = (u16*)smem;
    u16* sV = sW + 128 * 136;
    const int tid = opaque_tid(), lane = tid & 63, wave = tid >> 6;
    __syncthreads();
    const float* wg = p.sgu_w + (size_t)g * 128 * 128;
    f32x4 wv[16];
#pragma unroll
    for (int i = 0; i < 16; ++i) wv[i] = *(const f32x4*)(wg + (tid + 256 * i) * 4);
    const u16* VA = (const u16*)(ws + OFF_VA);
    const int ch0 = (tid & 15) * 8;
    float lg[8], lbv[8];
#pragma unroll
    for (int j = 0; j < 8; ++j) { lg[j] = p.sgu_ln_g[g * 128 + ch0 + j]; lbv[j] = p.sgu_ln_b[g * 128 + ch0 + j]; }
    u32x4 rawv[8];
#pragma unroll
    for (int ps = 0; ps < 8; ++ps) rawv[ps] = *(const u32x4*)(VA + (p0 + (tid >> 4) + 16 * ps) * 1024 + g * 128 + ch0);
#pragma unroll
    for (int i = 0; i < 16; ++i) {
        const int e = (tid + 256 * i) * 4;
        const int t = e >> 7, s = e & 127;
        const float4 v = make_float4(wv[i][0], wv[i][1], wv[i][2], wv[i][3]);
        const float a0 = (s + 0 <= t) ? v.x : 0.f, a1 = (s + 1 <= t) ? v.y : 0.f, a2 = (s + 2 <= t) ? v.z : 0.f, a3 = (s + 3 <= t) ? v.w : 0.f;
        *(uint2*)(sW + t * 136 + s) = make_uint2(pack2(a0, a1), pack2(a2, a3));
    }
#pragma unroll 2
    for (int ps = 0; ps < 8; ++ps) {
        const int s = (tid >> 4) + 16 * ps;
        const u32x4 raw = rawv[ps];
        float v[8];
        v[0] = bflo(raw[0]); v[1] = bfhi(raw[0]); v[2] = bflo(raw[1]); v[3] = bfhi(raw[1]);
        v[4] = bflo(raw[2]); v[5] = bfhi(raw[2]); v[6] = bflo(raw[3]); v[7] = bfhi(raw[3]);
        float sm = 0.f;
#pragma unroll
        for (int j = 0; j < 8; ++j) sm += v[j];
#pragma unroll
        for (int o = 8; o > 0; o >>= 1) sm += __shfl_xor(sm, o);
        const float mu = sm * (1.f / 128.f);
        float q = 0.f;
#pragma unroll
        for (int j = 0; j < 8; ++j) { v[j] -= mu; q += v[j] * v[j]; }
#pragma unroll
        for (int o = 8; o > 0; o >>= 1) q += __shfl_xor(q, o);
        const float rs = rsqrtf(q * (1.f / 128.f) + LN_EPS);
#pragma unroll
        for (int j = 0; j < 8; ++j) v[j] = v[j] * rs * lg[j] + lbv[j];
        *(uint4*)(sV + s * 128 + ch0) = make_uint4(pack2(v[0], v[1]), pack2(v[2], v[3]), pack2(v[4], v[5]), pack2(v[6], v[7]));
    }
    __syncthreads();
    const int wm = wave >> 1, wn = wave & 1;
    f32x16 acc[2][2];
#pragma unroll
    for (int i = 0; i < 2; ++i)
#pragma unroll
        for (int j = 0; j < 2; ++j)
#pragma unroll
            for (int r = 0; r < 16; ++r) acc[i][j][r] = 0.f;
    const int nks = (wm + 1) * 4;
    for (int ks = 0; ks < nks; ++ks) {
        bf16x8 af[2], bf[2];
#pragma unroll
        for (int i = 0; i < 2; ++i) af[i] = *(const bf16x8*)(sW + (wm * 64 + i * 32 + (lane & 31)) * 136 + ks * 16 + (lane >> 5) * 8);
#pragma unroll
        for (int j = 0; j < 2; ++j) bf[j] = ld_frag_strided(sV + (ks * 16 + (lane >> 5) * 8) * 128 + wn * 64 + j * 32 + (lane & 31), 128);
#pragma unroll
        for (int i = 0; i < 2; ++i)
#pragma unroll
            for (int j = 0; j < 2; ++j)
                acc[i][j] = __builtin_amdgcn_mfma_f32_32x32x16_bf16(bf[j], af[i], acc[i][j], 0, 0, 0);
    }
    const u16* UA = (const u16*)(ws + OFF_UA);
    u16* Y = (u16*)(ws + OFF_RC);
#pragma unroll
    for (int i = 0; i < 2; ++i) {
        const int t = wm * 64 + i * 32 + (lane & 31);
        const float bias = p.sgu_b[g * 128 + t];
        uint2 ur[2][4];
#pragma unroll
        for (int j = 0; j < 2; ++j)
#pragma unroll
            for (int gq = 0; gq < 4; ++gq) {
                const int d = wn * 64 + j * 32 + 8 * gq + 4 * (lane >> 5);
                ur[j][gq] = *(const uint2*)(UA + (p0 + t) * 1024 + g * 128 + d);
            }
#pragma unroll
        for (int j = 0; j < 2; ++j)
#pragma unroll
            for (int gq = 0; gq < 4; ++gq) {
                const int d = wn * 64 + j * 32 + 8 * gq + 4 * (lane >> 5);
                const f32x4 o = {bflo(ur[j][gq].x) * (acc[i][j][4 * gq] + bias), bfhi(ur[j][gq].x) * (acc[i][j][4 * gq + 1] + bias),
                                 bflo(ur[j][gq].y) * (acc[i][j][4 * gq + 2] + bias), bfhi(ur[j][gq].y) * (acc[i][j][4 * gq + 3] + bias)};
                st_bf4(Y + (p0 + t) * DM + g * 128 + d, o);
            }
    }
}

__device__ __forceinline__ void hgrn_a_item(const Params& p, int idx, unsigned char* smem) {
    unsigned char* ws = p.ws;
    const int b = idx >> 9, h = (idx >> 6) & 7, c = idx & 63;
    const size_t p0 = (size_t)b * SEQ + (size_t)c * 64;
    u16* sKL = (u16*)smem;
    u16* sI = sKL + 64 * 128;
    float* tot = (float*)(sI + 64 * 128);
    const int tid = opaque_tid(), lane = tid & 63, wave = tid >> 6;
    const int k = tid & 127, half = tid >> 7;
    __syncthreads();
    const float* LF = (const float*)(ws + OFF_LF) + (p0 + half * 32) * 1024 + h * 128 + k;
    float lfv[32];
    float run = 0.f;
#pragma unroll
    for (int s = 0; s < 32; ++s) { lfv[s] = LF[(size_t)s * 1024]; run += lfv[s]; }
    if (half == 0) tot[k] = run; else tot[128 + k] = run;
    const u16* IB = (const u16*)(ws + OFF_IB);
#pragma unroll
    for (int i = 0; i < 4; ++i) {
        const int cidx = tid + 256 * i;
        const int s = cidx >> 4, v8 = (cidx & 15) * 8;
        *(uint4*)(sI + s * 128 + v8) = *(const uint4*)(IB + (p0 + s) * 1024 + h * 128 + v8);
    }
    __syncthreads();
    const float t0 = tot[k];
    const float alast = t0 + tot[128 + k];
    float a = half ? t0 : 0.f;
#pragma unroll
    for (int s = 0; s < 32; ++s) {
        a += lfv[s];
        const float kl = (1.f - __expf(lfv[s])) * __expf(alast - a);
        sKL[(half * 32 + s) * 128 + k] = f2bf(kl);
    }
    if (half == 0) ((float*)(ws + OFF_DEC))[(size_t)idx * 128 + k] = __expf(alast);
    __syncthreads();
    const int wm = wave >> 1, wn = wave & 1;
    f32x16 acc[2][2];
#pragma unroll
    for (int i = 0; i < 2; ++i)
#pragma unroll
        for (int j = 0; j < 2; ++j)
#pragma unroll
            for (int r = 0; r < 16; ++r) acc[i][j][r] = 0.f;
#pragma unroll 1
    for (int ks = 0; ks < 4; ++ks) {
        bf16x8 af[2], bf[2];
        const int kr = (ks * 16 + (lane >> 5) * 8) * 128;
#pragma unroll
        for (int i = 0; i < 2; ++i) af[i] = ld_frag_strided(sI + kr + wm * 64 + i * 32 + (lane & 31), 128);
#pragma unroll
        for (int j = 0; j < 2; ++j) bf[j] = ld_frag_strided(sKL + kr + wn * 64 + j * 32 + (lane & 31), 128);
#pragma unroll
        for (int i = 0; i < 2; ++i)
#pragma unroll
            for (int j = 0; j < 2; ++j)
                acc[i][j] = __builtin_amdgcn_mfma_f32_32x32x16_bf16(bf[j], af[i], acc[i][j], 0, 0, 0);
    }
    float* UT = (float*)(ws + OFF_UT) + (size_t)idx * 16384;
#pragma unroll
    for (int i = 0; i < 2; ++i)
#pragma unroll
        for (int j = 0; j < 2; ++j)
#pragma unroll
            for (int g = 0; g < 4; ++g) {
                const int v = wm * 64 + i * 32 + (lane & 31);
                const int kk = wn * 64 + j * 32 + 8 * g + 4 * (lane >> 5);
                *(f32x4*)(UT + v * 128 + kk) = f32x4{acc[i][j][4 * g], acc[i][j][4 * g + 1], acc[i][j][4 * g + 2], acc[i][j][4 * g + 3]};
            }
}

__device__ __forceinline__ void phase2(const Params& p, unsigned char* smem) {
    unsigned char* ws = p.ws;
    const int NIT = 512 + 1024 + 256 + 256 + 256;
    for (int it = blockIdx.x; it < NIT; it += gridDim.x) {
        if (it < 1024) {
            hgrn_a_item(p, it, smem);
        } else if (it < 1536) {
            sgu_item(p, it - 1024, smem);
        } else if (it < 1792) {
            const int q = it - 1536;
            const int bh = q >> 5, mt = (q >> 4) & 1, nt = q & 15;
            const int b = bh >> 2, h = bh & 3;
            const u16* A = (const u16*)(ws + OFF_KP) + (size_t)(b * 256 + mt * 128) * DM + h * 512;
            const u16* Bt = (const u16*)(ws + OFF_WQ_B) + (size_t)(nt * 128) * DM + h * 512;
            u16* O = (u16*)(ws + OFF_WQKT) + (size_t)b * 1024 * DM + (size_t)(h * 256 + mt * 128) * DM + nt * 128;
            gemm_tile(A, DM, Bt, DM, 512, smem, [&](int r, int c, f32x4 v) { st_bf4(O + (size_t)r * DM + c, v * 0.04419417382415922f); });
        } else if (it < 2048) {
            const int q = it - 1792;
            const int bh = q >> 5, mt = (q >> 1) & 15, nt = q & 1;
            const int b = bh >> 2, h = bh & 3;
            const u16* A = (const u16*)(ws + OFF_WT_O) + (size_t)(mt * 128) * DM + h * 512;
            const u16* Bt = (const u16*)(ws + OFF_VP) + (size_t)(b * 256 + nt * 128) * DM + h * 512;
            u16* O = (u16*)(ws + OFF_WVOT) + (size_t)b * 2048 * 1024 + (size_t)(mt * 128) * 1024 + h * 256 + nt * 128;
            gemm_tile(A, DM, Bt, DM, 512, smem, [&](int r, int c, f32x4 v) { st_bf4(O + (size_t)r * 1024 + c, v); });
        } else {
            const int q = it - 2048;
            const int hp = q >> 4, nt = q & 15;
            const u16* A = (const u16*)(ws + ((hp & 1) ? OFF_K2B : OFF_K1B));
            const u16* Bt = (const u16*)(ws + OFF_PWQ_B) + (size_t)(nt * 128) * DM + hp * 128;
            u16* O = (u16*)(ws + OFF_WSKT) + (size_t)(hp * 128) * DM + nt * 128;
            gemm_tile(A, 128, Bt, DM, 128, smem, [&](int r, int c, f32x4 v) { st_bf4(O + (size_t)r * DM + c, v); });
        }
    }
}

__device__ __forceinline__ void phase3(const Params& p) {
    unsigned char* ws = p.ws;
    const float* UT = (const float*)(ws + OFF_UT);
    const float* DEC = (const float*)(ws + OFF_DEC);
    u16* ST = (u16*)(ws + OFF_ST);
    const int tid = opaque_tid();
    const int nth = gridDim.x * 256;
    for (int e0 = blockIdx.x * 256 + tid; e0 < 8 * 16384; e0 += nth) {
        const int bh0 = e0 >> 14, vk = e0 & 16383, k = vk & 127, bh1 = bh0 + 8;
        float S0 = 0.f, S1 = 0.f;
        const float* up0 = UT + (size_t)bh0 * 64 * 16384 + vk;
        const float* up1 = UT + (size_t)bh1 * 64 * 16384 + vk;
        const float* dp0 = DEC + (size_t)bh0 * 64 * 128 + k;
        const float* dp1 = DEC + (size_t)bh1 * 64 * 128 + k;
        u16* sp0 = ST + (size_t)bh0 * 64 * 16384 + vk;
        u16* sp1 = ST + (size_t)bh1 * 64 * 16384 + vk;
#pragma unroll 1
        for (int cb = 0; cb < 64; cb += 16) {
            float u0[16], u1[16], d0[16], d1[16];
#pragma unroll
            for (int c = 0; c < 16; ++c) {
                u0[c] = up0[(size_t)(cb + c) * 16384]; u1[c] = up1[(size_t)(cb + c) * 16384];
                d0[c] = dp0[(cb + c) * 128]; d1[c] = dp1[(cb + c) * 128];
            }
#pragma unroll
            for (int c = 0; c < 16; ++c) {
                sp0[(size_t)(cb + c) * 16384] = f2bf(S0);
                sp1[(size_t)(cb + c) * 16384] = f2bf(S1);
                S0 = d0[c] * S0 + u0[c];
                S1 = d1[c] * S1 + u1[c];
            }
        }
    }
}

__device__ __forceinline__ void hgrn_c_item(const Params& p, int idx, unsigned char* smem) {
    unsigned char* ws = p.ws;
    const int b = idx >> 9, h = (idx >> 6) & 7, c = idx & 63;
    const size_t p0 = (size_t)b * SEQ + (size_t)c * 64;
    u16* sQE = (u16*)smem;
    u16* sKE = sQE + 64 * 136;
    u16* sI = sKE + 64 * 136;
    u16* sP = sI + 64 * 128;
    float* tot = (float*)(sP + 64 * 72);
    float* sO = (float*)smem;
    const int tid = opaque_tid(), lane = tid & 63, wave = tid >> 6;
    const int k = tid & 127, half = tid >> 7;
    __syncthreads();
    const float* LF = (const float*)(ws + OFF_LF) + (p0 + half * 32) * 1024 + h * 128 + k;
    float lfv[32];
    float run = 0.f;
#pragma unroll
    for (int s = 0; s < 32; ++s) { lfv[s] = LF[(size_t)s * 1024]; run += lfv[s]; }
    if (half == 0) tot[k] = run;
    const u16* QB = (const u16*)(ws + OFF_QB) + (p0 + half * 32) * 1024 + h * 128 + k;
    u16 qv[32];
#pragma unroll
    for (int s = 0; s < 32; ++s) qv[s] = QB[(size_t)s * 1024];
    const u16* IB = (const u16*)(ws + OFF_IB);
    u32x4 ibv[4];
#pragma unroll
    for (int i = 0; i < 4; ++i) {
        const int cidx = tid + 256 * i;
        ibv[i] = *(const u32x4*)(IB + (p0 + (cidx >> 4)) * 1024 + h * 128 + (cidx & 15) * 8);
    }
    bf16x8 stf[8][2];
    {
        const u16* STp = (const u16*)(ws + OFF_ST) + (size_t)idx * 16384;
        const int vn_ = wave & 1;
#pragma unroll
        for (int ks = 0; ks < 8; ++ks)
#pragma unroll
            for (int j = 0; j < 2; ++j)
                stf[ks][j] = *(const bf16x8*)(STp + (vn_ * 64 + j * 32 + (lane & 31)) * 128 + ks * 16 + (lane >> 5) * 8);
    }
#pragma unroll
    for (int i = 0; i < 4; ++i) {
        const int cidx = tid + 256 * i;
        *(u32x4*)(sI + (cidx >> 4) * 128 + (cidx & 15) * 8) = ibv[i];
    }
    __syncthreads();
    float a = half ? tot[k] : 0.f;
#pragma unroll
    for (int s = 0; s < 32; ++s) {
        a += lfv[s];
        const float q = bf2f(qv[s]);
        const int t = half * 32 + s;
        sQE[t * 136 + k] = f2bf(q * __expf(a));
        sKE[t * 136 + k] = f2bf((1.f - __expf(lfv[s])) * __expf(fminf(-a, 80.f)));
    }
    __syncthreads();
    {
        const int tm = wave >> 1, sn = wave & 1;
        f32x16 sc;
#pragma unroll
        for (int r = 0; r < 16; ++r) sc[r] = 0.f;
        if (sn <= tm) {
#pragma unroll
            for (int ks = 0; ks < 8; ++ks) {
                const bf16x8 af = *(const bf16x8*)(sQE + (tm * 32 + (lane & 31)) * 136 + ks * 16 + (lane >> 5) * 8);
                const bf16x8 bf = *(const bf16x8*)(sKE + (sn * 32 + (lane & 31)) * 136 + ks * 16 + (lane >> 5) * 8);
                sc = __builtin_amdgcn_mfma_f32_32x32x16_bf16(af, bf, sc, 0, 0, 0);
            }
        }
#pragma unroll
        for (int r = 0; r < 16; ++r) {
            const int t = tm * 32 + (r & 3) + 8 * (r >> 2) + 4 * (lane >> 5);
            const int s = sn * 32 + (lane & 31);
            const float v = (s <= t) ? sc[r] : 0.f;
            sP[t * 72 + s] = f2bf(v);
        }
    }
    __syncthreads();
    const int tm = wave >> 1, vn = wave & 1;
    f32x16 acc[2];
#pragma unroll
    for (int j = 0; j < 2; ++j)
#pragma unroll
        for (int r = 0; r < 16; ++r) acc[j][r] = 0.f;
    {
        const int nks = (tm + 1) * 2;
        for (int ks = 0; ks < nks; ++ks) {
            const bf16x8 af = *(const bf16x8*)(sP + (tm * 32 + (lane & 31)) * 72 + ks * 16 + (lane >> 5) * 8);
#pragma unroll
            for (int j = 0; j < 2; ++j) {
                const bf16x8 bf = ld_frag_strided(sI + (ks * 16 + (lane >> 5) * 8) * 128 + vn * 64 + j * 32 + (lane & 31), 128);
                acc[j] = __builtin_amdgcn_mfma_f32_32x32x16_bf16(af, bf, acc[j], 0, 0, 0);
            }
        }
#pragma unroll
        for (int ks = 0; ks < 8; ++ks) {
            const bf16x8 af = *(const bf16x8*)(sQE + (tm * 32 + (lane & 31)) * 136 + ks * 16 + (lane >> 5) * 8);
#pragma unroll
            for (int j = 0; j < 2; ++j) acc[j] = __builtin_amdgcn_mfma_f32_32x32x16_bf16(af, stf[ks][j], acc[j], 0, 0, 0);
        }
    }
    __syncthreads();
#pragma unroll
    for (int j = 0; j < 2; ++j)
#pragma unroll
        for (int r = 0; r < 16; ++r) {
            const int t = tm * 32 + (r & 3) + 8 * (r >> 2) + 4 * (lane >> 5);
            const int v = vn * 64 + j * 32 + (lane & 31);
            sO[t * 132 + v] = acc[j][r];
        }
    __syncthreads();
    {
        const int t = tid >> 2, q = tid & 3;
        float o[32];
        float ss = 0.f;
#pragma unroll
        for (int i = 0; i < 4; ++i) {
            const float4 a = *(const float4*)(sO + t * 132 + (i * 4 + q) * 8), bq = *(const float4*)(sO + t * 132 + (i * 4 + q) * 8 + 4);
            o[i * 8 + 0] = a.x; o[i * 8 + 1] = a.y; o[i * 8 + 2] = a.z; o[i * 8 + 3] = a.w;
            o[i * 8 + 4] = bq.x; o[i * 8 + 5] = bq.y; o[i * 8 + 6] = bq.z; o[i * 8 + 7] = bq.w;
        }
#pragma unroll
        for (int i = 0; i < 32; ++i) ss += o[i] * o[i];
        ss += __shfl_xor(ss, 1);
        ss += __shfl_xor(ss, 2);
        const float rs = rsqrtf(ss * (1.f / 128.f) + LN_EPS);
        const u16* GB = (const u16*)(ws + OFF_GB) + (p0 + t) * 1024 + h * 128;
        u16* Y = (u16*)(ws + OFF_RC) + (p0 + t) * DM + 1024 + h * 128;
        const float* gn = p.hgrn_g + h * 128;
        u32x4 gr[4];
        f32x4 gnv[4][2];
#pragma unroll
        for (int i = 0; i < 4; ++i) {
            gr[i] = *(const u32x4*)(GB + (i * 4 + q) * 8);
            gnv[i][0] = *(const f32x4*)(gn + (i * 4 + q) * 8); gnv[i][1] = *(const f32x4*)(gn + (i * 4 + q) * 8 + 4);
        }
#pragma unroll
        for (int i = 0; i < 4; ++i) {
            const int v0 = (i * 4 + q) * 8;
            const float4 g0 = make_float4(gnv[i][0][0], gnv[i][0][1], gnv[i][0][2], gnv[i][0][3]);
            const float4 g1 = make_float4(gnv[i][1][0], gnv[i][1][1], gnv[i][1][2], gnv[i][1][3]);
            u32x4 w;
            w[0] = pack2(o[i * 8 + 0] * rs * g0.x * bflo(gr[i][0]), o[i * 8 + 1] * rs * g0.y * bfhi(gr[i][0]));
            w[1] = pack2(o[i * 8 + 2] * rs * g0.z * bflo(gr[i][1]), o[i * 8 + 3] * rs * g0.w * bfhi(gr[i][1]));
            w[2] = pack2(o[i * 8 + 4] * rs * g1.x * bflo(gr[i][2]), o[i * 8 + 5] * rs * g1.y * bfhi(gr[i][2]));
            w[3] = pack2(o[i * 8 + 6] * rs * g1.z * bflo(gr[i][3]), o[i * 8 + 7] * rs * g1.w * bfhi(gr[i][3]));
            *(u32x4*)(Y + v0) = w;
        }
    }
}

__device__ __forceinline__ void phase8(const Params& p) {
    unsigned char* ws = p.ws;
    const float* SC = (const float*)(ws + OFF_SC);
    u16* PB = (u16*)(ws + OFF_PB);
    const int tid = opaque_tid(); const int lane = tid & 63, wave = tid >> 6;
    const int stride = gridDim.x * 4;
    int row = blockIdx.x * 4 + wave;
    f32x4 tv4[4];
    if (row < NTOK) {
#pragma unroll
        for (int i = 0; i < 4; ++i) tv4[i] = *(const f32x4*)(SC + (size_t)row * 1024 + lane * 16 + i * 4);
    }
    for (; row < NTOK; row += stride) {
        float v[16];
#pragma unroll
        for (int i = 0; i < 4; ++i) { v[4 * i] = tv4[i][0]; v[4 * i + 1] = tv4[i][1]; v[4 * i + 2] = tv4[i][2]; v[4 * i + 3] = tv4[i][3]; }
        const int nrow = row + stride;
        if (nrow < NTOK) {
#pragma unroll
            for (int i = 0; i < 4; ++i) tv4[i] = *(const f32x4*)(SC + (size_t)nrow * 1024 + lane * 16 + i * 4);
        }
        float m = v[0];
#pragma unroll
        for (int i = 1; i < 16; ++i) m = fmaxf(m, v[i]);
#pragma unroll
        for (int o = 8; o > 0; o >>= 1) m = fmaxf(m, __shfl_xor(m, o));
        float s = 0.f;
#pragma unroll
        for (int i = 0; i < 16; ++i) { v[i] = __expf(v[i] - m); s += v[i]; }
#pragma unroll
        for (int o = 8; o > 0; o >>= 1) s += __shfl_xor(s, o);
        const float inv = 1.f / s;
        uint32_t o[8];
#pragma unroll
        for (int i = 0; i < 8; ++i) o[i] = pack2(v[2 * i] * inv, v[2 * i + 1] * inv);
        u32x4* dp = (u32x4*)(PB + (size_t)row * 1024 + lane * 16);
        dp[0] = u32x4{o[0], o[1], o[2], o[3]};
        dp[1] = u32x4{o[4], o[5], o[6], o[7]};
    }
}

__device__ __forceinline__ void phase12(const Params& p, unsigned char* smem) {
    unsigned char* ws = p.ws;
    const float* PS = (const float*)(ws + OFF_RD);
    const float* X2 = (const float*)(ws + OFF_RE);
    const unsigned char* UB = ws + OFF_UB;
    const unsigned char* VB = ws + OFF_VB;
    const float* SU = (const float*)(ws + OFF_SU);
    const float* SV = (const float*)(ws + OFF_SV);
    float* part = (float*)smem;
    float* sv = part + 4 * 2048;
    float* tv = sv + 4 * 128;
    int* ti = (int*)(tv + 256);
    float* selv = (float*)(ti + 256);
    int* sele = (int*)(selv + 128);
    float* gate = (float*)(sele + 128);
    float* red = gate + 128;
    const int tid = opaque_tid(), lane = tid & 63, wave = tid >> 6;
    int ci = 0, cj = 0;
    {
        int start = 0;
#pragma unroll
        for (int ii = 0; ii < 16; ++ii) {
            const int cnt = 16 / (ii + 1);
            if (lane >= start && lane < start + cnt) { ci = ii; cj = lane - start; }
            start += cnt;
        }
    }
    const float NEG_INF = -__builtin_huge_valf();
    const f32x4 l3g0 = *(const f32x4*)(p.ln3_g + tid * 8), l3g1 = *(const f32x4*)(p.ln3_g + tid * 8 + 4);
    const f32x4 l3b0 = *(const f32x4*)(p.ln3_b + tid * 8), l3b1 = *(const f32x4*)(p.ln3_b + tid * 8 + 4);
    int* nxt = (int*)(red + 8);
    unsigned* tok_ctr = (unsigned*)(ws + OFF_BAR) + 3600;
    if (tid == 0) nxt[0] = (int)__hip_atomic_fetch_add(tok_ctr, 1u, __ATOMIC_RELAXED, __HIP_MEMORY_SCOPE_AGENT);
    __syncthreads();
    int tok = nxt[0];
    for (int it = 0; tok < NTOK; ++it) {
        __syncthreads();
        if (tid == 0) nxt[(it + 1) & 1] = (int)__hip_atomic_fetch_add(tok_ctr, 1u, __ATOMIC_RELAXED, __HIP_MEMORY_SCOPE_AGENT);
        float* svw = sv + wave * 128;
        unsigned* svk = (unsigned*)svw;
        float pv0[4], pv1[4];
#pragma unroll
        for (int gi = 0; gi < 4; ++gi) {
            const float* src = PS + (size_t)tok * DM + (wave * 4 + gi) * 128;
            pv0[gi] = src[lane]; pv1[gi] = src[lane + 64];
        }
        const float* xrow = X2 + (size_t)tok * DM;
        f32x4 xq[8];
#pragma unroll
        for (int q = 0; q < 2; ++q)
#pragma unroll
            for (int i = 0; i < 4; ++i) xq[q * 4 + i] = *(const f32x4*)(xrow + q * 1024 + lane * 16 + i * 4);
        const f32x4 xres0 = *(const f32x4*)(xrow + tid * 8), xres1 = *(const f32x4*)(xrow + tid * 8 + 4);
#pragma unroll
        for (int gi = 0; gi < 4; ++gi) {
            const int g = wave * 4 + gi;
            const float v0 = pv0[gi], v1 = pv1[gi];
            const unsigned k0 = (sort_key(v0) & ~127u) | (unsigned)(127 - lane);
            const unsigned k1 = (sort_key(v1) & ~127u) | (unsigned)(63 - lane);
            svk[lane] = k0; svk[lane + 64] = k1;
            int r0 = 0, r1 = 0;
#pragma unroll 8
            for (int j4 = 0; j4 < 32; ++j4) {
                const u32x4 q = ((const u32x4*)svk)[j4];
#pragma unroll
                for (int cc = 0; cc < 4; ++cc) {
                    asm("v_cmp_gt_u32 vcc, %1, %2\n\tv_addc_co_u32 %0, vcc, 0, %0, vcc" : "+v"(r0) : "v"(q[cc]), "v"(k0) : "vcc");
                    asm("v_cmp_gt_u32 vcc, %1, %2\n\tv_addc_co_u32 %0, vcc, 0, %0, vcc" : "+v"(r1) : "v"(q[cc]), "v"(k1) : "vcc");
                }
            }
            if (r0 < 16) { tv[g * 16 + r0] = v0; ti[g * 16 + r0] = lane; }
            if (r1 < 16) { tv[g * 16 + r1] = v1; ti[g * 16 + r1] = lane + 64; }
        }
        __syncthreads();
        for (int hi = 0; hi < 2; ++hi) {
            const int h = wave * 2 + hi;
            float cv = NEG_INF; int ce = 0;
            if (lane < 50) {
                cv = tv[(h * 2) * 16 + ci] + tv[(h * 2 + 1) * 16 + cj];
                ce = ti[(h * 2) * 16 + ci] * 128 + ti[(h * 2 + 1) * 16 + cj];
            }
            const unsigned ck = (sort_key(cv) & ~63u) | (unsigned)(63 - lane);
            svk[lane] = ck;
            int rk = 0;
#pragma unroll
            for (int j4 = 0; j4 < 16; ++j4) {
                const u32x4 q = ((const u32x4*)svk)[j4];
#pragma unroll
                for (int cc = 0; cc < 4; ++cc) asm("v_cmp_gt_u32 vcc, %1, %2\n\tv_addc_co_u32 %0, vcc, 0, %0, vcc" : "+v"(rk) : "v"(q[cc]), "v"(ck) : "vcc");
            }
            if (rk < 16) { selv[h * 16 + rk] = cv; sele[h * 16 + rk] = ce; }
            const float mv = selv[h * 16];
            float ev = 0.f;
            if (lane < 16) ev = __expf(selv[h * 16 + lane] - mv);
            float sm = ev;
#pragma unroll
            for (int o = 8; o > 0; o >>= 1) sm += __shfl_xor(sm, o);
            if (lane < 16) gate[h * 16 + lane] = ev / sm;
        }
        __syncthreads();
        f32x2 xr[16];
#pragma unroll
        for (int q = 0; q < 2; ++q)
#pragma unroll
            for (int i = 0; i < 4; ++i) {
                const f32x4 a = xq[q * 4 + i];
                xr[q * 8 + i * 2 + 0] = f32x2{a[0], a[1]}; xr[q * 8 + i * 2 + 1] = f32x2{a[2], a[3]};
            }
        f32x2 acc[16];
#pragma unroll
        for (int i = 0; i < 16; ++i) acc[i] = f32x2{0.f, 0.f};
#pragma unroll 1
        for (int i0 = 0; i0 < 32; i0 += 4) {
            u32x4 ru[4][2];
            u32x4 rv[4][2];
            int e[4];
            float su[4], sv4[4];
#pragma unroll
            for (int u = 0; u < 4; ++u) {
                e[u] = sele[wave * 32 + i0 + u];
                su[u] = SU[e[u]]; sv4[u] = SV[e[u]];
            }
#pragma unroll
            for (int u = 0; u < 4; ++u) {
                const unsigned char* rowp = UB + (size_t)e[u] * DM + lane * 16;
#pragma unroll
                for (int q = 0; q < 2; ++q) ru[u][q] = *(const u32x4*)(rowp + q * 1024);
            }
#pragma unroll
            for (int u = 0; u < 4; ++u) {
                const unsigned char* rowp = VB + (size_t)e[u] * DM + lane * 16;
#pragma unroll
                for (int q = 0; q < 2; ++q) rv[u][q] = *(const u32x4*)(rowp + q * 1024);
            }
            float d[4];
#pragma unroll
            for (int u = 0; u < 4; ++u) {
                f32x2 d2 = f32x2{0.f, 0.f};
#pragma unroll
                for (int q = 0; q < 2; ++q)
#pragma unroll
                    for (int i = 0; i < 4; ++i) {
                        const int w = (int)ru[u][q][i];
                        const f32x2 lo = __builtin_amdgcn_cvt_pk_f32_fp8(w, false);
                        const f32x2 hi = __builtin_amdgcn_cvt_pk_f32_fp8(w, true);
                        d2 = xr[q * 8 + i * 2 + 0] * lo + d2;
                        d2 = xr[q * 8 + i * 2 + 1] * hi + d2;
                    }
                d[u] = d2[0] + d2[1];
            }
            const bool up = (lane & 32) != 0;
            const float s0 = up ? d[0] : d[2], s1 = up ? d[1] : d[3];
            const float k0 = (up ? d[2] : d[0]) + __shfl_xor(s0, 32);
            const float k1 = (up ? d[3] : d[1]) + __shfl_xor(s1, 32);
            const bool up2 = (lane & 16) != 0;
            float val = (up2 ? k1 : k0) + __shfl_xor(up2 ? k0 : k1, 16);
#pragma unroll
            for (int o = 8; o > 0; o >>= 1) val += __shfl_xor(val, o);
            float wgt[4];
#pragma unroll
            for (int u = 0; u < 4; ++u) {
                const float tot = __uint_as_float(__builtin_amdgcn_readlane(__float_as_uint(val), u * 16)) * su[u];
                wgt[u] = gate[wave * 32 + i0 + u] * gelu_t(tot) * sv4[u];
            }
#pragma unroll
            for (int u = 0; u < 4; ++u) {
                const f32x2 w2 = f32x2{wgt[u], wgt[u]};
#pragma unroll
                for (int q = 0; q < 2; ++q)
#pragma unroll
                    for (int i = 0; i < 4; ++i) {
                        const int w = (int)rv[u][q][i];
                        const f32x2 lo = __builtin_amdgcn_cvt_pk_f32_fp8(w, false);
                        const f32x2 hi = __builtin_amdgcn_cvt_pk_f32_fp8(w, true);
                        acc[q * 8 + i * 2 + 0] = w2 * lo + acc[q * 8 + i * 2 + 0];
                        acc[q * 8 + i * 2 + 1] = w2 * hi + acc[q * 8 + i * 2 + 1];
                    }
            }
        }
#pragma unroll
        for (int q = 0; q < 2; ++q)
#pragma unroll
            for (int i = 0; i < 4; ++i) {
                float* pp = part + wave * 2048 + q * 1024 + lane * 16 + i * 4;
                *(float4*)(pp) = make_float4(acc[q * 8 + i * 2][0], acc[q * 8 + i * 2][1], acc[q * 8 + i * 2 + 1][0], acc[q * 8 + i * 2 + 1][1]);
            }
        __syncthreads();
        float rr[8];
        {
            rr[0] = DN_ALPHA * xres0[0]; rr[1] = DN_ALPHA * xres0[1]; rr[2] = DN_ALPHA * xres0[2]; rr[3] = DN_ALPHA * xres0[3];
            rr[4] = DN_ALPHA * xres1[0]; rr[5] = DN_ALPHA * xres1[1]; rr[6] = DN_ALPHA * xres1[2]; rr[7] = DN_ALPHA * xres1[3];
#pragma unroll
            for (int w = 0; w < 4; ++w) {
                const float4 a = *(const float4*)(part + w * 2048 + tid * 8), bq = *(const float4*)(part + w * 2048 + tid * 8 + 4);
                rr[0] += a.x; rr[1] += a.y; rr[2] += a.z; rr[3] += a.w; rr[4] += bq.x; rr[5] += bq.y; rr[6] += bq.z; rr[7] += bq.w;
            }
        }
        float s = 0.f;
#pragma unroll
        for (int j = 0; j < 8; ++j) s += rr[j];
        s = wsum(s);
        if (lane == 0) red[wave] = s;
        __syncthreads();
        const float mu = (red[0] + red[1] + red[2] + red[3]) * (1.f / DM);
        float qv = 0.f;
#pragma unroll
        for (int j = 0; j < 8; ++j) { rr[j] -= mu; qv += rr[j] * rr[j]; }
        qv = wsum(qv);
        if (lane == 0) red[4 + wave] = qv;
        __syncthreads();
        const float rs = rsqrtf((red[4] + red[5] + red[6] + red[7]) * (1.f / DM) + LN_EPS);
        float* op = p.out + (size_t)tok * DM + tid * 8;
        *(float4*)(op) = make_float4(rr[0] * rs * l3g0[0] + l3b0[0], rr[1] * rs * l3g0[1] + l3b0[1], rr[2] * rs * l3g0[2] + l3b0[2], rr[3] * rs * l3g0[3] + l3b0[3]);
        *(float4*)(op + 4) = make_float4(rr[4] * rs * l3g1[0] + l3b1[0], rr[5] * rs * l3g1[1] + l3b1[1], rr[6] * rs * l3g1[2] + l3b1[2], rr[7] * rs * l3g1[3] + l3b1[3]);
        tok = nxt[(it + 1) & 1];
    }
}

__device__ __forceinline__ void run_phase(int ph, const Params& p, unsigned char* smem, const int vbid) {
    unsigned char* ws = p.ws;
    switch (ph) {
    case 0: phase0(p, smem); break;
    case 1: phase1(p, smem, vbid); break;
    case 2: phase2(p, smem); break;
    case 3: phase3(p); break;
    case 4:
        for (int it = blockIdx.x; it < 1024; it += gridDim.x) hgrn_c_item(p, it, smem);
        break;
    case 5: {
        float* R1 = (float*)(ws + OFF_RD);
        FOR_TILES_XCD_BIG(16, m, n) {
            const int tile = m * 16 + n;
            const u16* A = (const u16*)(ws + OFF_RC) + (size_t)m * 256 * DM;
            const u16* Bt = (const u16*)(ws + OFF_WT_OUT) + (size_t)n * 128 * DM;
            const float* xr = p.x + (size_t)m * 256 * DM + n * 128;
            float* o = R1 + (size_t)m * 256 * DM + n * 128;
            gemm_tile_big(A, DM, Bt, DM, DM, smem, [&](int r, int c, f32x4 v) { *(f32x4*)(o + (size_t)r * DM + c) = v; }, xr, DM, DN_ALPHA);
            cvt_fp8_rows(p.peer_u, ws + OFF_UB, (float*)(ws + OFF_SU), tile * 32, tile * 32 + 32);
        }
    } break;
    case 6:
        ln_rows((const float*)(ws + OFF_RD), p.ln1_g, p.ln1_b, (float*)(ws + OFF_RE), (u16*)(ws + OFF_RC));
        break;
    case 7: {
        float* SC = (float*)(ws + OFF_SC);
        FOR_TILES_XCD(8, m, n) {
            const int b = m >> 5;
            const u16* A = (const u16*)(ws + OFF_RC) + (size_t)m * 128 * DM;
            const u16* Bt = (const u16*)(ws + OFF_WQKT) + (size_t)b * 1024 * DM + (size_t)n * 128 * DM;
            float* o = SC + (size_t)m * 128 * 1024 + n * 128;
            gemm_tile(A, DM, Bt, DM, DM, smem, [&](int r, int c, f32x4 v) { *(f32x4*)(o + (size_t)r * 1024 + c) = v; });
        }
    } break;
    case 8:
        phase8(p);
        break;
    case 9: {
        float* R2 = (float*)(ws + OFF_RD);
        const float* X1 = (const float*)(ws + OFF_RE);
        FOR_TILES_XCD_BIG(16, m, n) {
            const int tile = m * 16 + n;
            const int b = m >> 4;
            const u16* A = (const u16*)(ws + OFF_PB) + (size_t)m * 256 * 1024;
            const u16* Bt = (const u16*)(ws + OFF_WVOT) + (size_t)b * 2048 * 1024 + (size_t)n * 128 * 1024;
            const float* xr = X1 + (size_t)m * 256 * DM + n * 128;
            float* o = R2 + (size_t)m * 256 * DM + n * 128;
            gemm_tile_big(A, 1024, Bt, 1024, 1024, smem, [&](int r, int c, f32x4 v) { *(f32x4*)(o + (size_t)r * DM + c) = v; }, xr, DM, DN_ALPHA);
            cvt_fp8_rows(p.peer_v, ws + OFF_VB, (float*)(ws + OFF_SV), tile * 32, tile * 32 + 32);
        }
    } break;
    case 10:
        ln_rows((const float*)(ws + OFF_RD), p.ln2_g, p.ln2_b, (float*)(ws + OFF_RE), (u16*)(ws + OFF_RC));
        break;
    case 11: {
        float* PS = (float*)(ws + OFF_RD);
        FOR_TILES_XCD_BIG(16, m, n) {
            const u16* A = (const u16*)(ws + OFF_RC) + (size_t)m * 256 * DM;
            const u16* Bt = (const u16*)(ws + OFF_WSKT) + (size_t)n * 128 * DM;
            float* o = PS + (size_t)m * 256 * DM + n * 128;
            gemm_tile_big(A, DM, Bt, DM, DM, smem, [&](int r, int c, f32x4 v) { *(f32x4*)(o + (size_t)r * DM + c) = v; });
        }
    } break;
    case 12: phase12(p, smem); break;
    default: break;
    }
}

__global__ void __launch_bounds__(256, 2) fwd_kernel(Params p) {
    __shared__ __attribute__((aligned(16))) unsigned char smem_raw[SMEM_BYTES + 16];
    unsigned char* smem = smem_raw + 16;
    const bool multi = (p.ph_hi - p.ph_lo) > 1;
    XcdBarrier bar;
    if (multi) {
        if (threadIdx.x == 0) *(uint4*)smem_raw = make_uint4(0u, 0u, 0u, 0u);
        __syncthreads();
        bar = xcd_barrier_post((unsigned*)(p.ws + OFF_BAR), (volatile LAS unsigned*)smem_raw);
    }
    int vbid = blockIdx.x;
    for (int ph = p.ph_lo; ph < p.ph_hi; ++ph) {
        run_phase(ph, p, smem, vbid);
        if (ph + 1 < p.ph_hi) {
            xcd_barrier(bar);
            if (ph == p.ph_lo) {
                if (threadIdx.x == 0) {
                    unsigned* bw = (unsigned*)(p.ws + OFF_BAR);
                    const unsigned per = gridDim.x >> 3;
                    bool ok = (gridDim.x & 7u) == 0u;
                    for (unsigned j = 0; j < 16; ++j) { const unsigned c = xb_ld(&bw[XB_XCNT(j)]); ok = ok && (c == (j < 8 ? per : 0u)); }
                    const unsigned tk = bar.st[2];
                    bar.st[3] = (ok && tk < per && bar.x < 8u) ? (tk * 8u + bar.x) : blockIdx.x;
                }
                __syncthreads();
                vbid = (int)bar.st[3];
                __syncthreads();
            }
        }
    }
}

extern "C" void kernel_launch(void* const* d_in, const int* in_sizes, int n_in, void* d_out, int out_size,
                              void* d_ws, size_t ws_size, hipStream_t stream) {
    static int grid = 0;
    if (grid == 0) {
        if (n_in != 25 || ws_size < OFF_END) { fprintf(stderr, "kernel_launch: unexpected n_in %d or ws_size %zu (< %zu)\n", n_in, ws_size, (size_t)OFF_END); grid = -1; return; }
        int dev = 0, cus = 0, per_cu = 0;
        hipGetDevice(&dev);
        hipDeviceGetAttribute(&cus, hipDeviceAttributeMultiprocessorCount, dev);
        hipOccupancyMaxActiveBlocksPerMultiprocessor(&per_cu, (const void*)fwd_kernel, 256, 0);
        if (per_cu > 2) per_cu = 2;
        if (per_cu < 1) per_cu = 1;
        grid = cus * per_cu;
    }
    if (grid < 0) return;
    Params p{};
    const float** pp = (const float**)&p;
    for (int i = 0; i < 25; ++i) pp[i] = (const float*)d_in[i];
    p.out = (float*)d_out;
    p.ws = (unsigned char*)d_ws;
#if ONE_LAUNCH
    hipMemsetAsync((unsigned char*)d_ws + OFF_BAR, 0, 16384, stream);
    p.ph_lo = 0; p.ph_hi = NPHASE;
    void* args[] = {&p};
    hipError_t e = hipLaunchCooperativeKernel((const void*)fwd_kernel, dim3(grid), dim3(256), args, 0, stream);
    if (e != hipSuccess) fprintf(stderr, "cooperative launch failed: %s (grid %d)\n", hipGetErrorString(e), grid);
#else
    for (int ph = 0; ph < NPHASE; ++ph) {
        p.ph_lo = ph; p.ph_hi = ph + 1;
        hipLaunchKernelGGL(fwd_kernel, dim3(grid), dim3(256), 0, stream, p);
    }
#endif
}
```

```cpp
#include <hip/hip_runtime.h>
#include <stdint.h>
#include <stdio.h>

#ifndef ONE_LAUNCH
#define ONE_LAUNCH 1
#endif

typedef unsigned short u16;
using bf16x8 = __attribute__((ext_vector_type(8))) short;
using f32x16 = __attribute__((ext_vector_type(16))) float;
using f32x2 = __attribute__((ext_vector_type(2))) float;
using f32x4 = __attribute__((ext_vector_type(4))) float;
using u32x4 = __attribute__((ext_vector_type(4))) unsigned int;

#define NTOK 8192
#define DM 2048
#define SEQ 4096
#define NPHASE 13
#define LN_EPS 1e-5f
#define DN_ALPHA 1.189207115002721f

constexpr size_t SZ_DD = (size_t)2048 * 2048 * 2;
constexpr size_t OFF_WT_IN = 0;
constexpr size_t OFF_WT_OUT = OFF_WT_IN + (size_t)6144 * 2048 * 2;
constexpr size_t OFF_WQ_B = OFF_WT_OUT + SZ_DD;
constexpr size_t OFF_WT_K = OFF_WQ_B + SZ_DD;
constexpr size_t OFF_WT_V = OFF_WT_K + SZ_DD;
constexpr size_t OFF_WT_O = OFF_WT_V + SZ_DD;
constexpr size_t OFF_PWQ_B = OFF_WT_O + SZ_DD;
constexpr size_t OFF_WQKT = OFF_PWQ_B + SZ_DD;
constexpr size_t OFF_WVOT = OFF_WQKT + SZ_DD;
constexpr size_t OFF_WSKT = OFF_WVOT + SZ_DD;
constexpr size_t OFF_MEMB = OFF_WSKT + SZ_DD;
constexpr size_t OFF_KP = OFF_MEMB + (size_t)512 * 2048 * 2;
constexpr size_t OFF_VP = OFF_KP + (size_t)512 * 2048 * 2;
constexpr size_t OFF_K1B = OFF_VP + (size_t)512 * 2048 * 2;
constexpr size_t OFF_K2B = OFF_K1B + 32768;
constexpr size_t OFF_DEC = OFF_K2B + 32768;
constexpr size_t OFF_BAR = OFF_DEC + (size_t)1024 * 128 * 4;
constexpr size_t OFF_RC = OFF_BAR + 16384;
constexpr size_t OFF_RD = OFF_RC + (size_t)NTOK * DM * 2;
constexpr size_t OFF_RE = OFF_RD + (size_t)NTOK * DM * 4;
constexpr size_t OFF_RA = OFF_RE + (size_t)NTOK * DM * 4;
constexpr size_t SZ_SEG = (size_t)NTOK * 1024 * 2;
constexpr size_t OFF_UA = OFF_RA;
constexpr size_t OFF_VA = OFF_UA + SZ_SEG;
constexpr size_t OFF_QB = OFF_VA + SZ_SEG;
constexpr size_t OFF_IB = OFF_QB + SZ_SEG;
constexpr size_t OFF_GB = OFF_IB + SZ_SEG;
constexpr size_t OFF_LF = OFF_GB + SZ_SEG;
constexpr size_t OFF_RB = OFF_LF + (size_t)NTOK * 1024 * 4;
constexpr size_t OFF_UT = OFF_RB;
constexpr size_t OFF_ST = OFF_UT + (size_t)1024 * 16384 * 4;
constexpr size_t OFF_END = OFF_ST + (size_t)1024 * 16384 * 2;
constexpr size_t OFF_UB = OFF_RA;
constexpr size_t OFF_VB = OFF_UB + (size_t)16384 * 2048;
constexpr size_t OFF_SU = OFF_VB + (size_t)16384 * 2048;
constexpr size_t OFF_SV = OFF_SU + 65536;
constexpr size_t OFF_SC = OFF_RB + (size_t)48 * 1048576;
constexpr size_t OFF_PB = OFF_RB + (size_t)80 * 1048576;
static_assert(OFF_SV + 65536 <= OFF_SC, "alias overlap");
static_assert(OFF_PB + (size_t)NTOK * 1024 * 2 <= OFF_END, "alias overflow");

#define SMEM_BYTES 74240

struct Params {
    const float* x; const float* mem; const float* w_in; const float* sgu_w; const float* sgu_b;
    const float* sgu_ln_g; const float* sgu_ln_b; const float* lb_logits; const float* hgrn_g;
    const float* w_out; const float* ln1_g; const float* ln1_b; const float* xa_wq; const float* xa_wk;
    const float* xa_wv; const float* xa_wo; const float* ln2_g; const float* ln2_b; const float* peer_wq;
    const float* peer_k1; const float* peer_k2; const float* peer_u; const float* peer_v;
    const float* ln3_g; const float* ln3_b;
    float* out; unsigned char* ws;
    int ph_lo; int ph_hi;
};

typedef __bf16 bf16x2_t __attribute__((ext_vector_type(2)));
__device__ __forceinline__ u16 f2bf(float f) { return __builtin_bit_cast(u16, (__bf16)f); }
__device__ __forceinline__ float bf2f(u16 h) { return __uint_as_float(((uint32_t)h) << 16); }
__device__ __forceinline__ uint32_t pack2(float a, float b) {
    f32x2 v = {a, b};
    return __builtin_bit_cast(uint32_t, __builtin_convertvector(v, bf16x2_t));
}
__device__ __forceinline__ void st_bf4(u16* p, f32x4 v) { *(uint2*)p = make_uint2(pack2(v[0], v[1]), pack2(v[2], v[3])); }
__device__ __forceinline__ float bflo(uint32_t w) { return __uint_as_float(w << 16); }
__device__ __forceinline__ float bfhi(uint32_t w) { return __uint_as_float(w & 0xffff0000u); }
__device__ __forceinline__ float gelu_t(float x) {
    float u = 0.7978845608028654f * (x + 0.044715f * x * x * x);
    return x * __builtin_amdgcn_rcpf(1.f + __expf(-2.f * u));
}
__device__ __forceinline__ float sigmoid_f(float x) { return __builtin_amdgcn_rcpf(1.f + __expf(-x)); }
__device__ __forceinline__ unsigned sort_key(float v) {
    const unsigned b = __float_as_uint(v);
    return (b & 0x80000000u) ? ~b : (b | 0x80000000u);
}
__device__ __forceinline__ float wsum(float v) {
#pragma unroll
    for (int o = 32; o > 0; o >>= 1) v += __shfl_xor(v, o);
    return v;
}

__device__ __forceinline__ void lds_barrier() {
    asm volatile("s_waitcnt lgkmcnt(0)" ::: "memory");
    __builtin_amdgcn_s_barrier();
    asm volatile("" ::: "memory");
}
__device__ __forceinline__ int opaque_tid() { int t = threadIdx.x; asm volatile("" : "+v"(t)); return t; }

#define XB_TMO      128
#define XB_XCNT(j)  (256  + 64 * (j))
#define XB_XSUB(j)  (1280 + 64 * (j))
#define XB_XGEN(j)  (2304 + 64 * (j))
#define XB_TOP      3328
#define XB_TOPGEN   3392
#define XCD_BAR_WORDS 3456
#define XB_SPIN_CAP (1u << 22)
#define LAS __attribute__((address_space(3)))
__device__ __forceinline__ unsigned xb_ld(unsigned* p) { return __hip_atomic_load(p, __ATOMIC_RELAXED, __HIP_MEMORY_SCOPE_AGENT); }
__device__ __forceinline__ unsigned xb_add(unsigned* p, unsigned v) { return __hip_atomic_fetch_add(p, v, __ATOMIC_RELAXED, __HIP_MEMORY_SCOPE_AGENT); }
__device__ __forceinline__ unsigned xb_xcc_id() { return (unsigned)__builtin_amdgcn_s_getreg((3 << 11) | 20) & 0xFu; }
#define XB_SPIN(cond, bar) do { unsigned _sp = 0; while (cond) { __builtin_amdgcn_s_sleep(1); \
    if ((++_sp & 255u) == 0u) { if (xb_ld(&(bar)[XB_TMO])) break; if (_sp > XB_SPIN_CAP) { atomicAdd(&(bar)[XB_TMO], 1u); break; } } } } while (0)
struct XcdBarrier { unsigned* bar; unsigned x; volatile LAS unsigned* st; };
__device__ __forceinline__ XcdBarrier xcd_barrier_post(unsigned* bar, volatile LAS unsigned* st) {
    XcdBarrier b; b.bar = bar; b.x = xb_xcc_id(); b.st = st;
    if (threadIdx.x == 0) st[2] = xb_add(&bar[XB_XCNT(b.x)], 1u);
    return b;
}
__device__ __forceinline__ void xcd_barrier_complete(unsigned* bar, unsigned x, unsigned& nloc, unsigned& nx) {
    const unsigned G = gridDim.x * gridDim.y * gridDim.z;
    unsigned sum, cnt, mine, sp = 0u;
    for (;;) {
        sum = 0u; cnt = 0u; mine = 0u;
#pragma unroll
        for (unsigned j = 0; j < 16; ++j) { const unsigned c = xb_ld(&bar[XB_XCNT(j)]); sum += c; cnt += (c > 0u) ? 1u : 0u; mine = (j == x) ? c : mine; }
        if (sum == G) break;
        __builtin_amdgcn_s_sleep(1);
        if ((++sp & 255u) == 0u) { if (xb_ld(&bar[XB_TMO])) break; if (sp > XB_SPIN_CAP) { atomicAdd(&bar[XB_TMO], 1u); break; } }
    }
    nloc = mine > 0u ? mine : 1u; nx = cnt > 0u ? cnt : 1u;
}
__device__ __forceinline__ void xcd_barrier(const XcdBarrier& b) {
    asm volatile("s_waitcnt vmcnt(0)" ::: "memory");
    __syncthreads();
    if (threadIdx.x == 0) {
        unsigned* bar = b.bar;
        __builtin_amdgcn_s_waitcnt(0);
        unsigned nloc = b.st[0], nx = b.st[1];
        if (nloc == 0u) { xcd_barrier_complete(bar, b.x, nloc, nx); b.st[0] = nloc; b.st[1] = nx; }
        const unsigned old = xb_add(&bar[XB_XSUB(b.x)], 1u);
        const unsigned gen = old / nloc;
        if (old + 1u == (gen + 1u) * nloc) {
            __builtin_amdgcn_fence(__ATOMIC_RELEASE, "agent");
            asm volatile("s_waitcnt vmcnt(0)" ::: "memory");
            const unsigned og = xb_add(&bar[XB_TOP], 1u);
            const unsigned tg = og / nx;
            if (og + 1u == (tg + 1u) * nx) xb_add(&bar[XB_TOPGEN], 1u);
            else XB_SPIN(xb_ld(&bar[XB_TOPGEN]) == tg, bar);
            __builtin_amdgcn_fence(__ATOMIC_ACQUIRE, "agent");
            xb_add(&bar[XB_XGEN(b.x)], 1u);
            asm volatile("s_waitcnt vmcnt(0)" ::: "memory");
        } else {
            XB_SPIN(xb_ld(&bar[XB_XGEN(b.x)]) == gen, bar);
            __builtin_amdgcn_fence(__ATOMIC_ACQUIRE, "agent");
            asm volatile("s_waitcnt vmcnt(0)" ::: "memory");
        }
    }
    __syncthreads();
}

template <class Epi>
__device__ __forceinline__ void gemm_tile(const u16* __restrict__ A, int lda, const u16* __restrict__ Bt, int ldb, int K,
                                          unsigned char* smem, Epi epi) {
    const int tid = opaque_tid(), lane = tid & 63, wave = tid >> 6;
    const int wm = wave >> 1, wn = wave & 1;
    f32x16 acc[2][2];
#pragma unroll
    for (int i = 0; i < 2; ++i)
#pragma unroll
        for (int j = 0; j < 2; ++j)
#pragma unroll
            for (int r = 0; r < 16; ++r) acc[i][j][r] = 0.f;
    const int lr = wave * 32 + (lane >> 3);
    const int lc = lane & 7;
    const u16* gA[4]; const u16* gB[4];
#pragma unroll
    for (int i = 0; i < 4; ++i) {
        const int row = lr + 8 * i;
        const int ch = lc ^ ((row >> 1) & 7);
        gA[i] = A + (size_t)row * lda + ch * 8;
        gB[i] = Bt + (size_t)row * ldb + ch * 8;
    }
    unsigned char* sbase = smem + wave * 4096;
    auto glds = [&](int k0, int buf) {
        unsigned char* dA = sbase + buf * 32768;
        unsigned char* dB = dA + 16384;
#pragma unroll
        for (int i = 0; i < 4; ++i) {
            __builtin_amdgcn_global_load_lds((const unsigned*)(gA[i] + k0), (__attribute__((address_space(3))) unsigned*)(dA + i * 1024), 16, 0, 0);
            __builtin_amdgcn_global_load_lds((const unsigned*)(gB[i] + k0), (__attribute__((address_space(3))) unsigned*)(dB + i * 1024), 16, 0, 0);
        }
    };
    int offA[2], offB[2], swA[2], swB[2];
#pragma unroll
    for (int i = 0; i < 2; ++i) {
        const int ra = wm * 64 + i * 32 + (lane & 31), rb = wn * 64 + i * 32 + (lane & 31);
        offA[i] = ra * 128; swA[i] = (ra >> 1) & 7;
        offB[i] = rb * 128; swB[i] = (rb >> 1) & 7;
    }
    const int half = lane >> 5;
    lds_barrier();
    glds(0, 0);
    asm volatile("s_waitcnt vmcnt(0)" ::: "memory");
    __syncthreads();
    const int nk = K >> 6;
    for (int kt = 0; kt < nk; ++kt) {
        const int buf = kt & 1;
        const int kn = ((kt + 1 < nk) ? (kt + 1) : kt) * 64;
        unsigned char* dA = sbase + (buf ^ 1) * 32768;
        unsigned char* dB = dA + 16384;
        const unsigned char* bA = smem + buf * 32768;
        const unsigned char* bB = bA + 16384;
#pragma unroll
        for (int ks = 0; ks < 4; ++ks) {
            bf16x8 af[2], bf[2];
            const int kc = ks * 2 + half;
#pragma unroll
            for (int i = 0; i < 2; ++i) af[i] = *(const bf16x8*)(bA + offA[i] + ((kc ^ swA[i]) << 4));
#pragma unroll
            for (int j = 0; j < 2; ++j) bf[j] = *(const bf16x8*)(bB + offB[j] + ((kc ^ swB[j]) << 4));
#pragma unroll
            for (int i = 0; i < 2; ++i)
#pragma unroll
                for (int j = 0; j < 2; ++j)
                    acc[i][j] = __builtin_amdgcn_mfma_f32_32x32x16_bf16(bf[j], af[i], acc[i][j], 0, 0, 0);
            __builtin_amdgcn_global_load_lds((const unsigned*)(gA[ks] + kn), (__attribute__((address_space(3))) unsigned*)(dA + ks * 1024), 16, 0, 0);
            __builtin_amdgcn_global_load_lds((const unsigned*)(gB[ks] + kn), (__attribute__((address_space(3))) unsigned*)(dB + ks * 1024), 16, 0, 0);
        }
        asm volatile("s_waitcnt vmcnt(0)" ::: "memory");
        __syncthreads();
    }
#pragma unroll
    for (int i = 0; i < 2; ++i)
#pragma unroll
        for (int j = 0; j < 2; ++j)
#pragma unroll
            for (int g = 0; g < 4; ++g) {
                const int row = wm * 64 + i * 32 + (lane & 31);
                const int col = wn * 64 + j * 32 + 8 * g + 4 * (lane >> 5);
                const f32x4 v = {acc[i][j][4 * g], acc[i][j][4 * g + 1], acc[i][j][4 * g + 2], acc[i][j][4 * g + 3]};
                epi(row, col, v);
            }
}

#define FOR_TILES_XCD(NT, m, n)                                                                   \
    for (int _t = (int)(vbid >> 3), _x = (int)(vbid & 7), _np = (int)(gridDim.x >> 3), \
             m = 0, n = 0;                                                                         \
         (_t < 8 * (NT)) && ((m = 8 * _x + ((_t & 63) >> 3)), (n = ((_t >> 6) << 3) + (_t & 7)), true); _t += _np)

template <class Epi>
__device__ __forceinline__ void gemm_tile_big(const u16* __restrict__ A, int lda, const u16* __restrict__ Bt, int ldb, int K,
                                              unsigned char* smem, Epi epi, const float* __restrict__ res = nullptr, int ldres = 0, float alpha = 0.f) {
    const int tid = opaque_tid(), lane = tid & 63, wave = tid >> 6;
    const int wm = wave >> 1, wn = wave & 1;
    f32x16 acc[4][2];
    if (res) {
#pragma unroll
        for (int i = 0; i < 4; ++i)
#pragma unroll
            for (int j = 0; j < 2; ++j)
#pragma unroll
                for (int g = 0; g < 4; ++g) {
                    const int row = wm * 128 + i * 32 + (lane & 31);
                    const int col = wn * 64 + j * 32 + 8 * g + 4 * (lane >> 5);
                    const f32x4 x = *(const f32x4*)(res + (size_t)row * ldres + col);
                    acc[i][j][4 * g] = alpha * x[0]; acc[i][j][4 * g + 1] = alpha * x[1];
                    acc[i][j][4 * g + 2] = alpha * x[2]; acc[i][j][4 * g + 3] = alpha * x[3];
                }
    } else {
#pragma unroll
        for (int i = 0; i < 4; ++i)
#pragma unroll
            for (int j = 0; j < 2; ++j)
#pragma unroll
                for (int r = 0; r < 16; ++r) acc[i][j][r] = 0.f;
    }
    const u16* gA[4]; const u16* gB[2];
#pragma unroll
    for (int i = 0; i < 4; ++i) {
        const int row = wave * 64 + i * 16 + (lane >> 2);
        gA[i] = A + (size_t)row * lda + (((lane & 3) ^ ((row >> 2) & 3)) << 3);
    }
#pragma unroll
    for (int i = 0; i < 2; ++i) {
        const int row = wave * 32 + i * 16 + (lane >> 2);
        gB[i] = Bt + (size_t)row * ldb + (((lane & 3) ^ ((row >> 2) & 3)) << 3);
    }
    auto glds = [&](int k0, int st) {
        unsigned char* dA = smem + st * 24576 + wave * 4096;
        unsigned char* dB = smem + st * 24576 + 16384 + wave * 2048;
#pragma unroll
        for (int i = 0; i < 4; ++i)
            __builtin_amdgcn_global_load_lds((const unsigned*)(gA[i] + k0), (__attribute__((address_space(3))) unsigned*)(dA + i * 1024), 16, 0, 0);
#pragma unroll
        for (int i = 0; i < 2; ++i)
            __builtin_amdgcn_global_load_lds((const unsigned*)(gB[i] + k0), (__attribute__((address_space(3))) unsigned*)(dB + i * 1024), 16, 0, 0);
    };
    int offA[4], swA[4], offB[2], swB[2];
#pragma unroll
    for (int i = 0; i < 4; ++i) { const int ra = wm * 128 + i * 32 + (lane & 31); offA[i] = ra * 64; swA[i] = (ra >> 2) & 3; }
#pragma unroll
    for (int j = 0; j < 2; ++j) { const int rb = wn * 64 + j * 32 + (lane & 31); offB[j] = 16384 + rb * 64; swB[j] = (rb >> 2) & 3; }
    const int half = lane >> 5;
    const int nk = K >> 5;
    lds_barrier();
    glds(0, 0);
    glds(32, 1);
    int st = 0;
    for (int kt = 0; kt < nk; ++kt) {
        asm volatile("s_waitcnt vmcnt(6)\n\ts_waitcnt lgkmcnt(0)" ::: "memory");
        __builtin_amdgcn_s_barrier();
        const int kn = ((kt + 2 < nk) ? (kt + 2) : (nk - 1)) * 32;
        const int sn = (st >= 1) ? (st - 1) : 2;
        unsigned char* dA = smem + sn * 24576 + wave * 4096;
        unsigned char* dB = smem + sn * 24576 + 16384 + wave * 2048;
        const unsigned char* bS = smem + st * 24576;
#pragma unroll
        for (int ks = 0; ks < 2; ++ks) {
            bf16x8 af[4], bf[2];
            const int kc = ks * 2 + half;
#pragma unroll
            for (int i = 0; i < 4; ++i) af[i] = *(const bf16x8*)(bS + offA[i] + ((kc ^ swA[i]) << 4));
#pragma unroll
            for (int j = 0; j < 2; ++j) bf[j] = *(const bf16x8*)(bS + offB[j] + ((kc ^ swB[j]) << 4));
#pragma unroll
            for (int i = 0; i < 4; ++i)
#pragma unroll
                for (int j = 0; j < 2; ++j)
                    acc[i][j] = __builtin_amdgcn_mfma_f32_32x32x16_bf16(bf[j], af[i], acc[i][j], 0, 0, 0);
            if (ks == 0) {
#pragma unroll
                for (int i = 0; i < 3; ++i)
                    __builtin_amdgcn_global_load_lds((const unsigned*)(gA[i] + kn), (__attribute__((address_space(3))) unsigned*)(dA + i * 1024), 16, 0, 0);
            } else {
                __builtin_amdgcn_global_load_lds((const unsigned*)(gA[3] + kn), (__attribute__((address_space(3))) unsigned*)(dA + 3 * 1024), 16, 0, 0);
#pragma unroll
                for (int i = 0; i < 2; ++i)
                    __builtin_amdgcn_global_load_lds((const unsigned*)(gB[i] + kn), (__attribute__((address_space(3))) unsigned*)(dB + i * 1024), 16, 0, 0);
            }
        }
        st = (st == 2) ? 0 : (st + 1);
    }
    asm volatile("s_waitcnt vmcnt(0)" ::: "memory");
#pragma unroll
    for (int i = 0; i < 4; ++i)
#pragma unroll
        for (int j = 0; j < 2; ++j)
#pragma unroll
            for (int g = 0; g < 4; ++g) {
                const int row = wm * 128 + i * 32 + (lane & 31);
                const int col = wn * 64 + j * 32 + 8 * g + 4 * (lane >> 5);
                const f32x4 v = {acc[i][j][4 * g], acc[i][j][4 * g + 1], acc[i][j][4 * g + 2], acc[i][j][4 * g + 3]};
                epi(row, col, v);
            }
}
#define FOR_TILES_XCD_BIG(NT, m, n)                                                               \
    for (int _t = (int)(vbid >> 3), _x = (int)(vbid & 7), _np = (int)(gridDim.x >> 3), \
             m = 0, n = 0;                                                                         \
         (_t < 4 * (NT)) && ((m = 4 * _x + ((_t & 31) >> 3)), (n = ((_t >> 5) << 3) + (_t & 7)), true); _t += _np)


__device__ __forceinline__ bf16x8 ld_frag_strided(const u16* p, int stride) {
    bf16x8 f;
#pragma unroll
    for (int j = 0; j < 8; ++j) f[j] = (short)p[j * stride];
    return f;
}

__device__ __forceinline__ void cvt_job(const float* __restrict__ src, u16* __restrict__ dst, size_t n, int bid, int nb) {
    const size_t nchunk = n / 8;
    const int tid = opaque_tid();
    const size_t S = (size_t)nb * 256;
    for (size_t c = (size_t)bid * 256 + tid; c < nchunk; c += 4 * S) {
        f32x4 a[4], b[4];
#pragma unroll
        for (int u = 0; u < 4; ++u) {
            const size_t cc = c + u * S;
            if (cc < nchunk) { a[u] = *(const f32x4*)(src + cc * 8); b[u] = *(const f32x4*)(src + cc * 8 + 4); }
        }
#pragma unroll
        for (int u = 0; u < 4; ++u) {
            const size_t cc = c + u * S;
            if (cc < nchunk) {
                u32x4 o;
                o[0] = pack2(a[u][0], a[u][1]); o[1] = pack2(a[u][2], a[u][3]); o[2] = pack2(b[u][0], b[u][1]); o[3] = pack2(b[u][2], b[u][3]);
                *(u32x4*)(dst + cc * 8) = o;
            }
        }
    }
}
__device__ __forceinline__ void cvt_fp8_rows(const float* __restrict__ src, unsigned char* __restrict__ dst, float* __restrict__ scl, int row_begin, int row_end) {
    const int tid = opaque_tid(); const int lane = tid & 63, wave = tid >> 6;
    for (int row0 = row_begin + wave * 2; row0 < row_end; row0 += 8) {
        float4 v[2][8];
#pragma unroll
        for (int rr = 0; rr < 2; ++rr)
#pragma unroll
            for (int q = 0; q < 2; ++q)
#pragma unroll
                for (int i = 0; i < 4; ++i)
                    v[rr][q * 4 + i] = *(const float4*)(src + (size_t)(row0 + rr) * 2048 + q * 1024 + lane * 16 + i * 4);
#pragma unroll
        for (int rr = 0; rr < 2; ++rr) {
            const int row = row0 + rr;
            float am = 0.f;
#pragma unroll
            for (int i = 0; i < 8; ++i)
                am = fmaxf(am, fmaxf(fmaxf(fabsf(v[rr][i].x), fabsf(v[rr][i].y)), fmaxf(fabsf(v[rr][i].z), fabsf(v[rr][i].w))));
#pragma unroll
            for (int o = 32; o > 0; o >>= 1) am = fmaxf(am, __shfl_xor(am, o));
            const float sc = am > 0.f ? 240.f / am : 1.f;
            if (lane == 0) scl[row] = am > 0.f ? am * (1.f / 240.f) : 1.f;
#pragma unroll
            for (int q = 0; q < 2; ++q) {
                u32x4 o;
#pragma unroll
                for (int i = 0; i < 4; ++i) {
                    int w = 0;
                    w = __builtin_amdgcn_cvt_pk_fp8_f32(v[rr][q * 4 + i].x * sc, v[rr][q * 4 + i].y * sc, w, false);
                    w = __builtin_amdgcn_cvt_pk_fp8_f32(v[rr][q * 4 + i].z * sc, v[rr][q * 4 + i].w * sc, w, true);
                    o[i] = (unsigned)w;
                }
                *(u32x4*)(dst + (size_t)row * 2048 + q * 1024 + lane * 16) = o;
            }
        }
    }
}
__device__ __forceinline__ void transpose_job(const float* __restrict__ W, u16* __restrict__ Wt, int Kd, int Nd, unsigned char* smem, int bid, int nb) {
    float* t = (float*)smem;
    const int tid = opaque_tid();
    const int tk = Kd / 64, tn = Nd / 64, nt = tk * tn;
    const int lk = tid >> 4, n4 = (tid & 15) * 4;
    f32x4 v[2][4];
#pragma unroll
    for (int u = 0; u < 2; ++u) {
        const int tile = bid + u * nb;
        if (tile < nt) {
            const int k0 = (tile / tn) * 64, n0 = (tile % tn) * 64;
#pragma unroll
            for (int i = 0; i < 4; ++i) v[u][i] = *(const f32x4*)(W + (size_t)(k0 + lk + 16 * i) * Nd + n0 + n4);
        }
    }
    for (int tile0 = bid; tile0 < nt; tile0 += 2 * nb) {
        lds_barrier();
#pragma unroll
        for (int u = 0; u < 2; ++u)
#pragma unroll
            for (int i = 0; i < 4; ++i) {
                float* tp = t + u * (64 * 65) + (lk + 16 * i) * 65 + n4;
                tp[0] = v[u][i][0]; tp[1] = v[u][i][1]; tp[2] = v[u][i][2]; tp[3] = v[u][i][3];
            }
        lds_barrier();
#pragma unroll
        for (int u = 0; u < 2; ++u) {
            const int nxt = tile0 + (2 + u) * nb;
            if (nxt < nt) {
                const int k1 = (nxt / tn) * 64, n1 = (nxt % tn) * 64;
#pragma unroll
                for (int i = 0; i < 4; ++i) v[u][i] = *(const f32x4*)(W + (size_t)(k1 + lk + 16 * i) * Nd + n1 + n4);
            }
        }
#pragma unroll
        for (int u = 0; u < 2; ++u) {
            const int tile = tile0 + u * nb;
            if (tile < nt) {
                const int k0 = (tile / tn) * 64, n0 = (tile % tn) * 64;
                const float* tb = t + u * (64 * 65);
                const int n = tid >> 2, kq = (tid & 3) * 16;
                uint32_t o[8];
#pragma unroll
                for (int j = 0; j < 8; ++j) o[j] = pack2(tb[(kq + 2 * j) * 65 + n], tb[(kq + 2 * j + 1) * 65 + n]);
                u32x4* dp = (u32x4*)(Wt + (size_t)(n0 + n) * Kd + k0 + kq);
                dp[0] = u32x4{o[0], o[1], o[2], o[3]};
                dp[1] = u32x4{o[4], o[5], o[6], o[7]};
            }
        }
    }
}

__device__ __forceinline__ void ln_rows(const float* __restrict__ in, const float* __restrict__ g, const float* __restrict__ b,
                        float* __restrict__ of, u16* __restrict__ ob) {
    const int tid = opaque_tid(); const int lane = tid & 63, wave = tid >> 6;
    float4 gv[8], bv[8];
#pragma unroll
    for (int i = 0; i < 8; ++i) { gv[i] = *(const float4*)(g + i * 256 + lane * 4); bv[i] = *(const float4*)(b + i * 256 + lane * 4); }
    const int stride = gridDim.x * 4;
    int row = blockIdx.x * 4 + wave;
    float4 v[8];
    if (row < NTOK) {
#pragma unroll
        for (int i = 0; i < 8; ++i) v[i] = *(const float4*)(in + (size_t)row * DM + i * 256 + lane * 4);
    }
    for (; row < NTOK; row += stride) {
        float s = 0.f;
#pragma unroll
        for (int i = 0; i < 8; ++i) s += v[i].x + v[i].y + v[i].z + v[i].w;
        const float mu = wsum(s) * (1.f / DM);
        float q = 0.f;
#pragma unroll
        for (int i = 0; i < 8; ++i) {
            const float a = v[i].x - mu, bb = v[i].y - mu, c = v[i].z - mu, d = v[i].w - mu;
            q += a * a + bb * bb + c * c + d * d;
        }
        const float rs = rsqrtf(wsum(q) * (1.f / DM) + LN_EPS);
        float4 o[8];
#pragma unroll
        for (int i = 0; i < 8; ++i) {
            o[i].x = (v[i].x - mu) * rs * gv[i].x + bv[i].x; o[i].y = (v[i].y - mu) * rs * gv[i].y + bv[i].y;
            o[i].z = (v[i].z - mu) * rs * gv[i].z + bv[i].z; o[i].w = (v[i].w - mu) * rs * gv[i].w + bv[i].w;
        }
        const int nrow = row + stride;
        if (nrow < NTOK) {
#pragma unroll
            for (int i = 0; i < 8; ++i) v[i] = *(const float4*)(in + (size_t)nrow * DM + i * 256 + lane * 4);
        }
#pragma unroll
        for (int i = 0; i < 8; ++i) {
            const int c0 = i * 256 + lane * 4;
            *(float4*)(of + (size_t)row * DM + c0) = o[i];
            *(uint2*)(ob + (size_t)row * DM + c0) = make_uint2(pack2(o[i].x, o[i].y), pack2(o[i].z, o[i].w));
        }
    }
}

__device__ __forceinline__ void phase0(const Params& p, unsigned char* smem) {
    unsigned char* ws = p.ws;
    const int bid = blockIdx.x, nb = gridDim.x;
    cvt_job(p.x, (u16*)(ws + OFF_RC), (size_t)NTOK * DM, bid, nb);
    cvt_job(p.mem, (u16*)(ws + OFF_MEMB), (size_t)512 * DM, bid, nb);
    transpose_job(p.w_in, (u16*)(ws + OFF_WT_IN), 2048, 6144, smem, bid, nb);
    transpose_job(p.xa_wk, (u16*)(ws + OFF_WT_K), 2048, 2048, smem, bid, nb);
    transpose_job(p.xa_wv, (u16*)(ws + OFF_WT_V), 2048, 2048, smem, bid, nb);
}
__device__ __forceinline__ void phase0_deferred(const Params& p, unsigned char* smem, int bid, int nb) {
    unsigned char* ws = p.ws;
    cvt_job(p.xa_wq, (u16*)(ws + OFF_WQ_B), (size_t)DM * DM, bid, nb);
    cvt_job(p.peer_wq, (u16*)(ws + OFF_PWQ_B), (size_t)DM * DM, bid, nb);
    cvt_job(p.peer_k1, (u16*)(ws + OFF_K1B), (size_t)128 * 128, bid, nb);
    cvt_job(p.peer_k2, (u16*)(ws + OFF_K2B), (size_t)128 * 128, bid, nb);
    transpose_job(p.w_out, (u16*)(ws + OFF_WT_OUT), 2048, 2048, smem, bid, nb);
    transpose_job(p.xa_wo, (u16*)(ws + OFF_WT_O), 2048, 2048, smem, bid, nb);
}

__device__ __forceinline__ void phase1(const Params& p, unsigned char* smem, const int vbid) {
    unsigned char* ws = p.ws;
    const u16* xb = (const u16*)(ws + OFF_RC);
    FOR_TILES_XCD_BIG(48, m, n) {
        {
            const int seg = n >> 3;
            const int cb = (n & 7) * 128;
            const u16* A = xb + (size_t)m * 256 * DM;
            const u16* Bt = (const u16*)(ws + OFF_WT_IN) + (size_t)n * 128 * DM;
            const size_t rbase = (size_t)m * 256;
            if (seg == 3) {
                float* LF = (float*)(ws + OFF_LF);
                float* lbs = (float*)(smem + 73728);
                __syncthreads();
                {
                    const int t2 = opaque_tid();
                    if (t2 < 128) lbs[t2] = sigmoid_f(p.lb_logits[cb + t2] - p.lb_logits[1024 + cb + t2]);
                }
                gemm_tile_big(A, DM, Bt, DM, DM, smem, [&](int r, int c, f32x4 v) {
                    const f32x4 lb4 = *(const f32x4*)(lbs + c);
                    f32x4 o;
#pragma unroll
                    for (int q = 0; q < 4; ++q) o[q] = __logf(lb4[q] + (1.f - lb4[q]) * sigmoid_f(v[q]));
                    *(f32x4*)(LF + (rbase + r) * 1024 + cb + c) = o;
                });
            } else {
                u16* O = (u16*)(ws + (seg == 0 ? OFF_UA : seg == 1 ? OFF_VA : seg == 2 ? OFF_QB : seg == 4 ? OFF_IB : OFF_GB));
                if (seg <= 1) {
                    gemm_tile_big(A, DM, Bt, DM, DM, smem, [&](int r, int c, f32x4 v) { st_bf4(O + (rbase + r) * 1024 + cb + c, f32x4{gelu_t(v[0]), gelu_t(v[1]), gelu_t(v[2]), gelu_t(v[3])}); });
                } else if (seg == 5) {
                    gemm_tile_big(A, DM, Bt, DM, DM, smem, [&](int r, int c, f32x4 v) { st_bf4(O + (rbase + r) * 1024 + cb + c, f32x4{v[0] * sigmoid_f(v[0]), v[1] * sigmoid_f(v[1]), v[2] * sigmoid_f(v[2]), v[3] * sigmoid_f(v[3])}); });
                } else {
                    gemm_tile_big(A, DM, Bt, DM, DM, smem, [&](int r, int c, f32x4 v) { st_bf4(O + (rbase + r) * 1024 + cb + c, v); });
                }
            }
        }
    }
    if ((int)gridDim.x > 128) {
        if ((int)blockIdx.x >= 128) phase0_deferred(p, smem, (int)blockIdx.x - 128, (int)gridDim.x - 128);
    } else {
        phase0_deferred(p, smem, (int)blockIdx.x, (int)gridDim.x);
    }
    for (int idx = blockIdx.x; idx < 128; idx += gridDim.x) {
        {
            const int which = idx >> 6, m = (idx & 63) >> 4, n = idx & 15;
            const u16* A = (const u16*)(ws + OFF_MEMB) + (size_t)m * 128 * DM;
            const u16* Bt = (const u16*)(ws + (which ? OFF_WT_V : OFF_WT_K)) + (size_t)n * 128 * DM;
            u16* O = (u16*)(ws + (which ? OFF_VP : OFF_KP));
            gemm_tile(A, DM, Bt, DM, DM, smem, [&](int r, int c, f32x4 v) { st_bf4(O + (size_t)(m * 128 + r) * DM + n * 128 + c, v); });
        }
    }
}

__device__ __forceinline__ void sgu_item(const Params& p, int idx, unsigned char* smem) {
    unsigned char* ws = p.ws;
    const int b = idx >> 8, c = (idx >> 3) & 31, g = idx & 7;
    const size_t p0 = (size_t)b * SEQ + (size_t)c * 128;
    u16* sW = (u16*)smem;
    u16* sV = sW + 128 * 136;
    const int tid = opaque_tid(), lane = tid & 63, wave = tid >> 6;
    lds_barrier();
    const float* wg = p.sgu_w + (size_t)g * 128 * 128;
    f32x4 wv[16];
#pragma unroll
    for (int i = 0; i < 16; ++i) wv[i] = *(const f32x4*)(wg + (tid + 256 * i) * 4);
    const u16* VA = (const u16*)(ws + OFF_VA);
    const int ch0 = (tid & 15) * 8;
    float lg[8], lbv[8];
#pragma unroll
    for (int j = 0; j < 8; ++j) { lg[j] = p.sgu_ln_g[g * 128 + ch0 + j]; lbv[j] = p.sgu_ln_b[g * 128 + ch0 + j]; }
    u32x4 rawv[8];
#pragma unroll
    for (int ps = 0; ps < 8; ++ps) rawv[ps] = *(const u32x4*)(VA + (p0 + (tid >> 4) + 16 * ps) * 1024 + g * 128 + ch0);
#pragma unroll
    for (int i = 0; i < 16; ++i) {
        const int e = (tid + 256 * i) * 4;
        const int t = e >> 7, s = e & 127;
        const float4 v = make_float4(wv[i][0], wv[i][1], wv[i][2], wv[i][3]);
        const float a0 = (s + 0 <= t) ? v.x : 0.f, a1 = (s + 1 <= t) ? v.y : 0.f, a2 = (s + 2 <= t) ? v.z : 0.f, a3 = (s + 3 <= t) ? v.w : 0.f;
        *(uint2*)(sW + t * 136 + s) = make_uint2(pack2(a0, a1), pack2(a2, a3));
    }
#pragma unroll 2
    for (int ps = 0; ps < 8; ++ps) {
        const int s = (tid >> 4) + 16 * ps;
        const u32x4 raw = rawv[ps];
        float v[8];
        v[0] = bflo(raw[0]); v[1] = bfhi(raw[0]); v[2] = bflo(raw[1]); v[3] = bfhi(raw[1]);
        v[4] = bflo(raw[2]); v[5] = bfhi(raw[2]); v[6] = bflo(raw[3]); v[7] = bfhi(raw[3]);
        float sm = 0.f;
#pragma unroll
        for (int j = 0; j < 8; ++j) sm += v[j];
#pragma unroll
        for (int o = 8; o > 0; o >>= 1) sm += __shfl_xor(sm, o);
        const float mu = sm * (1.f / 128.f);
        float q = 0.f;
#pragma unroll
        for (int j = 0; j < 8; ++j) { v[j] -= mu; q += v[j] * v[j]; }
#pragma unroll
        for (int o = 8; o > 0; o >>= 1) q += __shfl_xor(q, o);
        const float rs = rsqrtf(q * (1.f / 128.f) + LN_EPS);
#pragma unroll
        for (int j = 0; j < 8; ++j) v[j] = v[j] * rs * lg[j] + lbv[j];
        *(uint4*)(sV + s * 128 + ch0) = make_uint4(pack2(v[0], v[1]), pack2(v[2], v[3]), pack2(v[4], v[5]), pack2(v[6], v[7]));
    }
    lds_barrier();
    const int wm = wave >> 1, wn = wave & 1;
    f32x16 acc[2][2];
#pragma unroll
    for (int i = 0; i < 2; ++i)
#pragma unroll
        for (int j = 0; j < 2; ++j)
#pragma unroll
            for (int r = 0; r < 16; ++r) acc[i][j][r] = 0.f;
    const int nks = (wm + 1) * 4;
    for (int ks = 0; ks < nks; ++ks) {
        bf16x8 af[2], bf[2];
#pragma unroll
        for (int i = 0; i < 2; ++i) af[i] = *(const bf16x8*)(sW + (wm * 64 + i * 32 + (lane & 31)) * 136 + ks * 16 + (lane >> 5) * 8);
#pragma unroll
        for (int j = 0; j < 2; ++j) bf[j] = ld_frag_strided(sV + (ks * 16 + (lane >> 5) * 8) * 128 + wn * 64 + j * 32 + (lane & 31), 128);
#pragma unroll
        for (int i = 0; i < 2; ++i)
#pragma unroll
            for (int j = 0; j < 2; ++j)
                acc[i][j] = __builtin_amdgcn_mfma_f32_32x32x16_bf16(bf[j], af[i], acc[i][j], 0, 0, 0);
    }
    const u16* UA = (const u16*)(ws + OFF_UA);
    u16* Y = (u16*)(ws + OFF_RC);
#pragma unroll
    for (int i = 0; i < 2; ++i) {
        const int t = wm * 64 + i * 32 + (lane & 31);
        const float bias = p.sgu_b[g * 128 + t];
        uint2 ur[2][4];
#pragma unroll
        for (int j = 0; j < 2; ++j)
#pragma unroll
            for (int gq = 0; gq < 4; ++gq) {
                const int d = wn * 64 + j * 32 + 8 * gq + 4 * (lane >> 5);
                ur[j][gq] = *(const uint2*)(UA + (p0 + t) * 1024 + g * 128 + d);
            }
#pragma unroll
        for (int j = 0; j < 2; ++j)
#pragma unroll
            for (int gq = 0; gq < 4; ++gq) {
                const int d = wn * 64 + j * 32 + 8 * gq + 4 * (lane >> 5);
                const f32x4 o = {bflo(ur[j][gq].x) * (acc[i][j][4 * gq] + bias), bfhi(ur[j][gq].x) * (acc[i][j][4 * gq + 1] + bias),
                                 bflo(ur[j][gq].y) * (acc[i][j][4 * gq + 2] + bias), bfhi(ur[j][gq].y) * (acc[i][j][4 * gq + 3] + bias)};
                st_bf4(Y + (p0 + t) * DM + g * 128 + d, o);
            }
    }
}

__device__ __forceinline__ void hgrn_a_item(const Params& p, int idx, unsigned char* smem) {
    unsigned char* ws = p.ws;
    const int b = idx >> 9, h = (idx >> 6) & 7, c = idx & 63;
    const size_t p0 = (size_t)b * SEQ + (size_t)c * 64;
    u16* sKL = (u16*)smem;
    u16* sI = sKL + 64 * 128;
    float* tot = (float*)(sI + 64 * 128);
    const int tid = opaque_tid(), lane = tid & 63, wave = tid >> 6;
    const int k = tid & 127, half = tid >> 7;
    lds_barrier();
    const float* LF = (const float*)(ws + OFF_LF) + (p0 + half * 32) * 1024 + h * 128 + k;
    float lfv[32];
    float run = 0.f;
#pragma unroll
    for (int s = 0; s < 32; ++s) { lfv[s] = LF[(size_t)s * 1024]; run += lfv[s]; }
    if (half == 0) tot[k] = run; else tot[128 + k] = run;
    const u16* IB = (const u16*)(ws + OFF_IB);
#pragma unroll
    for (int i = 0; i < 4; ++i) {
        const int cidx = tid + 256 * i;
        const int s = cidx >> 4, v8 = (cidx & 15) * 8;
        *(uint4*)(sI + s * 128 + v8) = *(const uint4*)(IB + (p0 + s) * 1024 + h * 128 + v8);
    }
    lds_barrier();
    const float t0 = tot[k];
    const float alast = t0 + tot[128 + k];
    float a = half ? t0 : 0.f;
#pragma unroll
    for (int s = 0; s < 32; ++s) {
        a += lfv[s];
        const float kl = (1.f - __expf(lfv[s])) * __expf(alast - a);
        sKL[(half * 32 + s) * 128 + k] = f2bf(kl);
    }
    if (half == 0) ((float*)(ws + OFF_DEC))[(size_t)idx * 128 + k] = __expf(alast);
    lds_barrier();
    const int wm = wave >> 1, wn = wave & 1;
    f32x16 acc[2][2];
#pragma unroll
    for (int i = 0; i < 2; ++i)
#pragma unroll
        for (int j = 0; j < 2; ++j)
#pragma unroll
            for (int r = 0; r < 16; ++r) acc[i][j][r] = 0.f;
#pragma unroll 1
    for (int ks = 0; ks < 4; ++ks) {
        bf16x8 af[2], bf[2];
        const int kr = (ks * 16 + (lane >> 5) * 8) * 128;
#pragma unroll
        for (int i = 0; i < 2; ++i) af[i] = ld_frag_strided(sI + kr + wm * 64 + i * 32 + (lane & 31), 128);
#pragma unroll
        for (int j = 0; j < 2; ++j) bf[j] = ld_frag_strided(sKL + kr + wn * 64 + j * 32 + (lane & 31), 128);
#pragma unroll
        for (int i = 0; i < 2; ++i)
#pragma unroll
            for (int j = 0; j < 2; ++j)
                acc[i][j] = __builtin_amdgcn_mfma_f32_32x32x16_bf16(bf[j], af[i], acc[i][j], 0, 0, 0);
    }
    float* UT = (float*)(ws + OFF_UT) + (size_t)idx * 16384;
#pragma unroll
    for (int i = 0; i < 2; ++i)
#pragma unroll
        for (int j = 0; j < 2; ++j)
#pragma unroll
            for (int g = 0; g < 4; ++g) {
                const int v = wm * 64 + i * 32 + (lane & 31);
                const int kk = wn * 64 + j * 32 + 8 * g + 4 * (lane >> 5);
                *(f32x4*)(UT + v * 128 + kk) = f32x4{acc[i][j][4 * g], acc[i][j][4 * g + 1], acc[i][j][4 * g + 2], acc[i][j][4 * g + 3]};
            }
}

__device__ __forceinline__ void phase2(const Params& p, unsigned char* smem) {
    unsigned char* ws = p.ws;
    const int NIT = 512 + 1024 + 256 + 256 + 256;
    for (int it = blockIdx.x; it < NIT; it += gridDim.x) {
        if (it < 1024) {
            hgrn_a_item(p, it, smem);
        } else if (it < 1536) {
            sgu_item(p, it - 1024, smem);
        } else if (it < 1792) {
            const int q = it - 1536;
            const int bh = q >> 5, mt = (q >> 4) & 1, nt = q & 15;
            const int b = bh >> 2, h = bh & 3;
            const u16* A = (const u16*)(ws + OFF_KP) + (size_t)(b * 256 + mt * 128) * DM + h * 512;
            const u16* Bt = (const u16*)(ws + OFF_WQ_B) + (size_t)(nt * 128) * DM + h * 512;
            u16* O = (u16*)(ws + OFF_WQKT) + (size_t)b * 1024 * DM + (size_t)(h * 256 + mt * 128) * DM + nt * 128;
            gemm_tile(A, DM, Bt, DM, 512, smem, [&](int r, int c, f32x4 v) { st_bf4(O + (size_t)r * DM + c, v * 0.04419417382415922f); });
        } else if (it < 2048) {
            const int q = it - 1792;
            const int bh = q >> 5, mt = (q >> 1) & 15, nt = q & 1;
            const int b = bh >> 2, h = bh & 3;
            const u16* A = (const u16*)(ws + OFF_WT_O) + (size_t)(mt * 128) * DM + h * 512;
            const u16* Bt = (const u16*)(ws + OFF_VP) + (size_t)(b * 256 + nt * 128) * DM + h * 512;
            u16* O = (u16*)(ws + OFF_WVOT) + (size_t)b * 2048 * 1024 + (size_t)(mt * 128) * 1024 + h * 256 + nt * 128;
            gemm_tile(A, DM, Bt, DM, 512, smem, [&](int r, int c, f32x4 v) { st_bf4(O + (size_t)r * 1024 + c, v); });
        } else {
            const int q = it - 2048;
            const int hp = q >> 4, nt = q & 15;
            const u16* A = (const u16*)(ws + ((hp & 1) ? OFF_K2B : OFF_K1B));
            const u16* Bt = (const u16*)(ws + OFF_PWQ_B) + (size_t)(nt * 128) * DM + hp * 128;
            u16* O = (u16*)(ws + OFF_WSKT) + (size_t)(hp * 128) * DM + nt * 128;
            gemm_tile(A, 128, Bt, DM, 128, smem, [&](int r, int c, f32x4 v) { st_bf4(O + (size_t)r * DM + c, v); });
        }
    }
}

__device__ __forceinline__ void phase3(const Params& p) {
    unsigned char* ws = p.ws;
    const float* UT = (const float*)(ws + OFF_UT);
    const float* DEC = (const float*)(ws + OFF_DEC);
    u16* ST = (u16*)(ws + OFF_ST);
    const int tid = opaque_tid();
    const int nth = gridDim.x * 256;
    for (int e0 = blockIdx.x * 256 + tid; e0 < 8 * 16384; e0 += nth) {
        const int bh0 = e0 >> 14, vk = e0 & 16383, k = vk & 127, bh1 = bh0 + 8;
        float S0 = 0.f, S1 = 0.f;
        const float* up0 = UT + (size_t)bh0 * 64 * 16384 + vk;
        const float* up1 = UT + (size_t)bh1 * 64 * 16384 + vk;
        const float* dp0 = DEC + (size_t)bh0 * 64 * 128 + k;
        const float* dp1 = DEC + (size_t)bh1 * 64 * 128 + k;
        u16* sp0 = ST + (size_t)bh0 * 64 * 16384 + vk;
        u16* sp1 = ST + (size_t)bh1 * 64 * 16384 + vk;
#pragma unroll 1
        for (int cb = 0; cb < 64; cb += 16) {
            float u0[16], u1[16], d0[16], d1[16];
#pragma unroll
            for (int c = 0; c < 16; ++c) {
                u0[c] = up0[(size_t)(cb + c) * 16384]; u1[c] = up1[(size_t)(cb + c) * 16384];
                d0[c] = dp0[(cb + c) * 128]; d1[c] = dp1[(cb + c) * 128];
            }
#pragma unroll
            for (int c = 0; c < 16; ++c) {
                sp0[(size_t)(cb + c) * 16384] = f2bf(S0);
                sp1[(size_t)(cb + c) * 16384] = f2bf(S1);
                S0 = d0[c] * S0 + u0[c];
                S1 = d1[c] * S1 + u1[c];
            }
        }
    }
}

__device__ __forceinline__ void hgrn_c_item(const Params& p, int idx, unsigned char* smem) {
    unsigned char* ws = p.ws;
    const int b = idx >> 9, h = (idx >> 6) & 7, c = idx & 63;
    const size_t p0 = (size_t)b * SEQ + (size_t)c * 64;
    u16* sQE = (u16*)smem;
    u16* sKE = sQE + 64 * 136;
    u16* sI = sKE + 64 * 136;
    u16* sP = sI + 64 * 128;
    float* tot = (float*)(sP + 64 * 72);
    float* sO = (float*)smem;
    const int tid = opaque_tid(), lane = tid & 63, wave = tid >> 6;
    const int k = tid & 127, half = tid >> 7;
    lds_barrier();
    const float* LF = (const float*)(ws + OFF_LF) + (p0 + half * 32) * 1024 + h * 128 + k;
    float lfv[32];
    float run = 0.f;
#pragma unroll
    for (int s = 0; s < 32; ++s) { lfv[s] = LF[(size_t)s * 1024]; run += lfv[s]; }
    if (half == 0) tot[k] = run;
    const u16* QB = (const u16*)(ws + OFF_QB) + (p0 + half * 32) * 1024 + h * 128 + k;
    u16 qv[32];
#pragma unroll
    for (int s = 0; s < 32; ++s) qv[s] = QB[(size_t)s * 1024];
    const u16* IB = (const u16*)(ws + OFF_IB);
    u32x4 ibv[4];
#pragma unroll
    for (int i = 0; i < 4; ++i) {
        const int cidx = tid + 256 * i;
        ibv[i] = *(const u32x4*)(IB + (p0 + (cidx >> 4)) * 1024 + h * 128 + (cidx & 15) * 8);
    }
    bf16x8 stf[8][2];
    {
        const u16* STp = (const u16*)(ws + OFF_ST) + (size_t)idx * 16384;
        const int vn_ = wave & 1;
#pragma unroll
        for (int ks = 0; ks < 8; ++ks)
#pragma unroll
            for (int j = 0; j < 2; ++j)
                stf[ks][j] = *(const bf16x8*)(STp + (vn_ * 64 + j * 32 + (lane & 31)) * 128 + ks * 16 + (lane >> 5) * 8);
    }
#pragma unroll
    for (int i = 0; i < 4; ++i) {
        const int cidx = tid + 256 * i;
        *(u32x4*)(sI + (cidx >> 4) * 128 + (cidx & 15) * 8) = ibv[i];
    }
    lds_barrier();
    float a = half ? tot[k] : 0.f;
#pragma unroll
    for (int s = 0; s < 32; ++s) {
        a += lfv[s];
        const float q = bf2f(qv[s]);
        const int t = half * 32 + s;
        sQE[t * 136 + k] = f2bf(q * __expf(a));
        sKE[t * 136 + k] = f2bf((1.f - __expf(lfv[s])) * __expf(fminf(-a, 80.f)));
    }
    lds_barrier();
    {
        const int tm = wave >> 1, sn = wave & 1;
        f32x16 sc;
#pragma unroll
        for (int r = 0; r < 16; ++r) sc[r] = 0.f;
        if (sn <= tm) {
#pragma unroll
            for (int ks = 0; ks < 8; ++ks) {
                const bf16x8 af = *(const bf16x8*)(sQE + (tm * 32 + (lane & 31)) * 136 + ks * 16 + (lane >> 5) * 8);
                const bf16x8 bf = *(const bf16x8*)(sKE + (sn * 32 + (lane & 31)) * 136 + ks * 16 + (lane >> 5) * 8);
                sc = __builtin_amdgcn_mfma_f32_32x32x16_bf16(af, bf, sc, 0, 0, 0);
            }
        }
#pragma unroll
        for (int r = 0; r < 16; ++r) {
            const int t = tm * 32 + (r & 3) + 8 * (r >> 2) + 4 * (lane >> 5);
            const int s = sn * 32 + (lane & 31);
            const float v = (s <= t) ? sc[r] : 0.f;
            sP[t * 72 + s] = f2bf(v);
        }
    }
    lds_barrier();
    const int tm = wave >> 1, vn = wave & 1;
    f32x16 acc[2];
#pragma unroll
    for (int j = 0; j < 2; ++j)
#pragma unroll
        for (int r = 0; r < 16; ++r) acc[j][r] = 0.f;
    {
        const int nks = (tm + 1) * 2;
        for (int ks = 0; ks < nks; ++ks) {
            const bf16x8 af = *(const bf16x8*)(sP + (tm * 32 + (lane & 31)) * 72 + ks * 16 + (lane >> 5) * 8);
#pragma unroll
            for (int j = 0; j < 2; ++j) {
                const bf16x8 bf = ld_frag_strided(sI + (ks * 16 + (lane >> 5) * 8) * 128 + vn * 64 + j * 32 + (lane & 31), 128);
                acc[j] = __builtin_amdgcn_mfma_f32_32x32x16_bf16(af, bf, acc[j], 0, 0, 0);
            }
        }
#pragma unroll
        for (int ks = 0; ks < 8; ++ks) {
            const bf16x8 af = *(const bf16x8*)(sQE + (tm * 32 + (lane & 31)) * 136 + ks * 16 + (lane >> 5) * 8);
#pragma unroll
            for (int j = 0; j < 2; ++j) acc[j] = __builtin_amdgcn_mfma_f32_32x32x16_bf16(af, stf[ks][j], acc[j], 0, 0, 0);
        }
    }
    lds_barrier();
#pragma unroll
    for (int j = 0; j < 2; ++j)
#pragma unroll
        for (int r = 0; r < 16; ++r) {
            const int t = tm * 32 + (r & 3) + 8 * (r >> 2) + 4 * (lane >> 5);
            const int v = vn * 64 + j * 32 + (lane & 31);
            sO[t * 132 + v] = acc[j][r];
        }
    lds_barrier();
    {
        const int t = tid >> 2, q = tid & 3;
        float o[32];
        float ss = 0.f;
#pragma unroll
        for (int i = 0; i < 4; ++i) {
            const float4 a = *(const float4*)(sO + t * 132 + (i * 4 + q) * 8), bq = *(const float4*)(sO + t * 132 + (i * 4 + q) * 8 + 4);
            o[i * 8 + 0] = a.x; o[i * 8 + 1] = a.y; o[i * 8 + 2] = a.z; o[i * 8 + 3] = a.w;
            o[i * 8 + 4] = bq.x; o[i * 8 + 5] = bq.y; o[i * 8 + 6] = bq.z; o[i * 8 + 7] = bq.w;
        }
#pragma unroll
        for (int i = 0; i < 32; ++i) ss += o[i] * o[i];
        ss += __shfl_xor(ss, 1);
        ss += __shfl_xor(ss, 2);
        const float rs = rsqrtf(ss * (1.f / 128.f) + LN_EPS);
        const u16* GB = (const u16*)(ws + OFF_GB) + (p0 + t) * 1024 + h * 128;
        u16* Y = (u16*)(ws + OFF_RC) + (p0 + t) * DM + 1024 + h * 128;
        const float* gn = p.hgrn_g + h * 128;
        u32x4 gr[4];
        f32x4 gnv[4][2];
#pragma unroll
        for (int i = 0; i < 4; ++i) {
            gr[i] = *(const u32x4*)(GB + (i * 4 + q) * 8);
            gnv[i][0] = *(const f32x4*)(gn + (i * 4 + q) * 8); gnv[i][1] = *(const f32x4*)(gn + (i * 4 + q) * 8 + 4);
        }
#pragma unroll
        for (int i = 0; i < 4; ++i) {
            const int v0 = (i * 4 + q) * 8;
            const float4 g0 = make_float4(gnv[i][0][0], gnv[i][0][1], gnv[i][0][2], gnv[i][0][3]);
            const float4 g1 = make_float4(gnv[i][1][0], gnv[i][1][1], gnv[i][1][2], gnv[i][1][3]);
            u32x4 w;
            w[0] = pack2(o[i * 8 + 0] * rs * g0.x * bflo(gr[i][0]), o[i * 8 + 1] * rs * g0.y * bfhi(gr[i][0]));
            w[1] = pack2(o[i * 8 + 2] * rs * g0.z * bflo(gr[i][1]), o[i * 8 + 3] * rs * g0.w * bfhi(gr[i][1]));
            w[2] = pack2(o[i * 8 + 4] * rs * g1.x * bflo(gr[i][2]), o[i * 8 + 5] * rs * g1.y * bfhi(gr[i][2]));
            w[3] = pack2(o[i * 8 + 6] * rs * g1.z * bflo(gr[i][3]), o[i * 8 + 7] * rs * g1.w * bfhi(gr[i][3]));
            *(u32x4*)(Y + v0) = w;
        }
    }
}

__device__ __forceinline__ void phase8(const Params& p) {
    unsigned char* ws = p.ws;
    const float* SC = (const float*)(ws + OFF_SC);
    u16* PB = (u16*)(ws + OFF_PB);
    const int tid = opaque_tid(); const int lane = tid & 63, wave = tid >> 6;
    const int stride = gridDim.x * 4;
    int row = blockIdx.x * 4 + wave;
    f32x4 tv4[4];
    if (row < NTOK) {
#pragma unroll
        for (int i = 0; i < 4; ++i) tv4[i] = *(const f32x4*)(SC + (size_t)row * 1024 + lane * 16 + i * 4);
    }
    for (; row < NTOK; row += stride) {
        float v[16];
#pragma unroll
        for (int i = 0; i < 4; ++i) { v[4 * i] = tv4[i][0]; v[4 * i + 1] = tv4[i][1]; v[4 * i + 2] = tv4[i][2]; v[4 * i + 3] = tv4[i][3]; }
        const int nrow = row + stride;
        if (nrow < NTOK) {
#pragma unroll
            for (int i = 0; i < 4; ++i) tv4[i] = *(const f32x4*)(SC + (size_t)nrow * 1024 + lane * 16 + i * 4);
        }
        float m = v[0];
#pragma unroll
        for (int i = 1; i < 16; ++i) m = fmaxf(m, v[i]);
#pragma unroll
        for (int o = 8; o > 0; o >>= 1) m = fmaxf(m, __shfl_xor(m, o));
        float s = 0.f;
#pragma unroll
        for (int i = 0; i < 16; ++i) { v[i] = __expf(v[i] - m); s += v[i]; }
#pragma unroll
        for (int o = 8; o > 0; o >>= 1) s += __shfl_xor(s, o);
        const float inv = 1.f / s;
        uint32_t o[8];
#pragma unroll
        for (int i = 0; i < 8; ++i) o[i] = pack2(v[2 * i] * inv, v[2 * i + 1] * inv);
        u32x4* dp = (u32x4*)(PB + (size_t)row * 1024 + lane * 16);
        dp[0] = u32x4{o[0], o[1], o[2], o[3]};
        dp[1] = u32x4{o[4], o[5], o[6], o[7]};
    }
}

__device__ __forceinline__ void phase12(const Params& p, unsigned char* smem) {
    unsigned char* ws = p.ws;
    const float* PS = (const float*)(ws + OFF_RD);
    const float* X2 = (const float*)(ws + OFF_RE);
    const unsigned char* UB = ws + OFF_UB;
    const unsigned char* VB = ws + OFF_VB;
    const float* SU = (const float*)(ws + OFF_SU);
    const float* SV = (const float*)(ws + OFF_SV);
    float* part = (float*)smem;
    float* sv = part + 4 * 2048;
    float* tv = sv + 4 * 128;
    int* ti = (int*)(tv + 256);
    float* selv = (float*)(ti + 256);
    int* sele = (int*)(selv + 128);
    float* gate = (float*)(sele + 128);
    float* red = gate + 128;
    const int tid = opaque_tid(), lane = tid & 63, wave = tid >> 6;
    int ci = 0, cj = 0;
    {
        int start = 0;
#pragma unroll
        for (int ii = 0; ii < 16; ++ii) {
            const int cnt = 16 / (ii + 1);
            if (lane >= start && lane < start + cnt) { ci = ii; cj = lane - start; }
            start += cnt;
        }
    }
    const float NEG_INF = -__builtin_huge_valf();
    const f32x4 l3g0 = *(const f32x4*)(p.ln3_g + tid * 8), l3g1 = *(const f32x4*)(p.ln3_g + tid * 8 + 4);
    const f32x4 l3b0 = *(const f32x4*)(p.ln3_b + tid * 8), l3b1 = *(const f32x4*)(p.ln3_b + tid * 8 + 4);
    int* nxt = (int*)(red + 8);
    unsigned* tok_ctr = (unsigned*)(ws + OFF_BAR) + 3600;
    if (tid == 0) nxt[0] = (int)__hip_atomic_fetch_add(tok_ctr, 1u, __ATOMIC_RELAXED, __HIP_MEMORY_SCOPE_AGENT);
    lds_barrier();
    int tok = nxt[0];
    for (int it = 0; tok < NTOK; ++it) {
        lds_barrier();
        if (tid == 0) nxt[(it + 1) & 1] = (int)__hip_atomic_fetch_add(tok_ctr, 1u, __ATOMIC_RELAXED, __HIP_MEMORY_SCOPE_AGENT);
        float* svw = sv + wave * 128;
        unsigned* svk = (unsigned*)svw;
        float pv0[4], pv1[4];
#pragma unroll
        for (int gi = 0; gi < 4; ++gi) {
            const float* src = PS + (size_t)tok * DM + (wave * 4 + gi) * 128;
            pv0[gi] = src[lane]; pv1[gi] = src[lane + 64];
        }
        const float* xrow = X2 + (size_t)tok * DM;
        f32x4 xq[8];
#pragma unroll
        for (int q = 0; q < 2; ++q)
#pragma unroll
            for (int i = 0; i < 4; ++i) xq[q * 4 + i] = *(const f32x4*)(xrow + q * 1024 + lane * 16 + i * 4);
        const f32x4 xres0 = *(const f32x4*)(xrow + tid * 8), xres1 = *(const f32x4*)(xrow + tid * 8 + 4);
#pragma unroll
        for (int gi = 0; gi < 4; ++gi) {
            const int g = wave * 4 + gi;
            const float v0 = pv0[gi], v1 = pv1[gi];
            const unsigned k0 = (sort_key(v0) & ~127u) | (unsigned)(127 - lane);
            const unsigned k1 = (sort_key(v1) & ~127u) | (unsigned)(63 - lane);
            svk[lane] = k0; svk[lane + 64] = k1;
            int r0 = 0, r1 = 0;
#pragma unroll 8
            for (int j4 = 0; j4 < 32; ++j4) {
                const u32x4 q = ((const u32x4*)svk)[j4];
#pragma unroll
                for (int cc = 0; cc < 4; ++cc) {
                    asm("v_cmp_gt_u32 vcc, %1, %2\n\tv_addc_co_u32 %0, vcc, 0, %0, vcc" : "+v"(r0) : "v"(q[cc]), "v"(k0) : "vcc");
                    asm("v_cmp_gt_u32 vcc, %1, %2\n\tv_addc_co_u32 %0, vcc, 0, %0, vcc" : "+v"(r1) : "v"(q[cc]), "v"(k1) : "vcc");
                }
            }
            if (r0 < 16) { tv[g * 16 + r0] = v0; ti[g * 16 + r0] = lane; }
            if (r1 < 16) { tv[g * 16 + r1] = v1; ti[g * 16 + r1] = lane + 64; }
        }
        lds_barrier();
        for (int hi = 0; hi < 2; ++hi) {
            const int h = wave * 2 + hi;
            float cv = NEG_INF; int ce = 0;
            if (lane < 50) {
                cv = tv[(h * 2) * 16 + ci] + tv[(h * 2 + 1) * 16 + cj];
                ce = ti[(h * 2) * 16 + ci] * 128 + ti[(h * 2 + 1) * 16 + cj];
            }
            const unsigned ck = (sort_key(cv) & ~63u) | (unsigned)(63 - lane);
            svk[lane] = ck;
            int rk = 0;
#pragma unroll
            for (int j4 = 0; j4 < 16; ++j4) {
                const u32x4 q = ((const u32x4*)svk)[j4];
#pragma unroll
                for (int cc = 0; cc < 4; ++cc) asm("v_cmp_gt_u32 vcc, %1, %2\n\tv_addc_co_u32 %0, vcc, 0, %0, vcc" : "+v"(rk) : "v"(q[cc]), "v"(ck) : "vcc");
            }
            if (rk < 16) { selv[h * 16 + rk] = cv; sele[h * 16 + rk] = ce; }
            const float mv = selv[h * 16];
            float ev = 0.f;
            if (lane < 16) ev = __expf(selv[h * 16 + lane] - mv);
            float sm = ev;
#pragma unroll
            for (int o = 8; o > 0; o >>= 1) sm += __shfl_xor(sm, o);
            if (lane < 16) gate[h * 16 + lane] = ev / sm;
        }
        lds_barrier();
        f32x2 xr[16];
#pragma unroll
        for (int q = 0; q < 2; ++q)
#pragma unroll
            for (int i = 0; i < 4; ++i) {
                const f32x4 a = xq[q * 4 + i];
                xr[q * 8 + i * 2 + 0] = f32x2{a[0], a[1]}; xr[q * 8 + i * 2 + 1] = f32x2{a[2], a[3]};
            }
        f32x2 acc[16];
#pragma unroll
        for (int i = 0; i < 16; ++i) acc[i] = f32x2{0.f, 0.f};
#pragma unroll 1
        for (int i0 = 0; i0 < 32; i0 += 4) {
            u32x4 ru[4][2];
            u32x4 rv[4][2];
            int e[4];
            float su[4], sv4[4];
#pragma unroll
            for (int u = 0; u < 4; ++u) {
                e[u] = sele[wave * 32 + i0 + u];
                su[u] = SU[e[u]]; sv4[u] = SV[e[u]];
            }
#pragma unroll
            for (int u = 0; u < 4; ++u) {
                const unsigned char* rowp = UB + (size_t)e[u] * DM + lane * 16;
#pragma unroll
                for (int q = 0; q < 2; ++q) ru[u][q] = *(const u32x4*)(rowp + q * 1024);
            }
#pragma unroll
            for (int u = 0; u < 4; ++u) {
                const unsigned char* rowp = VB + (size_t)e[u] * DM + lane * 16;
#pragma unroll
                for (int q = 0; q < 2; ++q) rv[u][q] = *(const u32x4*)(rowp + q * 1024);
            }
            float d[4];
#pragma unroll
            for (int u = 0; u < 4; ++u) {
                f32x2 d2 = f32x2{0.f, 0.f};
#pragma unroll
                for (int q = 0; q < 2; ++q)
#pragma unroll
                    for (int i = 0; i < 4; ++i) {
                        const int w = (int)ru[u][q][i];
                        const f32x2 lo = __builtin_amdgcn_cvt_pk_f32_fp8(w, false);
                        const f32x2 hi = __builtin_amdgcn_cvt_pk_f32_fp8(w, true);
                        d2 = xr[q * 8 + i * 2 + 0] * lo + d2;
                        d2 = xr[q * 8 + i * 2 + 1] * hi + d2;
                    }
                d[u] = d2[0] + d2[1];
            }
            const bool up = (lane & 32) != 0;
            const float s0 = up ? d[0] : d[2], s1 = up ? d[1] : d[3];
            const float k0 = (up ? d[2] : d[0]) + __shfl_xor(s0, 32);
            const float k1 = (up ? d[3] : d[1]) + __shfl_xor(s1, 32);
            const bool up2 = (lane & 16) != 0;
            float val = (up2 ? k1 : k0) + __shfl_xor(up2 ? k0 : k1, 16);
#pragma unroll
            for (int o = 8; o > 0; o >>= 1) val += __shfl_xor(val, o);
            float wgt[4];
#pragma unroll
            for (int u = 0; u < 4; ++u) {
                const float tot = __uint_as_float(__builtin_amdgcn_readlane(__float_as_uint(val), u * 16)) * su[u];
                wgt[u] = gate[wave * 32 + i0 + u] * gelu_t(tot) * sv4[u];
            }
#pragma unroll
            for (int u = 0; u < 4; ++u) {
                const f32x2 w2 = f32x2{wgt[u], wgt[u]};
#pragma unroll
                for (int q = 0; q < 2; ++q)
#pragma unroll
                    for (int i = 0; i < 4; ++i) {
                        const int w = (int)rv[u][q][i];
                        const f32x2 lo = __builtin_amdgcn_cvt_pk_f32_fp8(w, false);
                        const f32x2 hi = __builtin_amdgcn_cvt_pk_f32_fp8(w, true);
                        acc[q * 8 + i * 2 + 0] = w2 * lo + acc[q * 8 + i * 2 + 0];
                        acc[q * 8 + i * 2 + 1] = w2 * hi + acc[q * 8 + i * 2 + 1];
                    }
            }
        }
#pragma unroll
        for (int q = 0; q < 2; ++q)
#pragma unroll
            for (int i = 0; i < 4; ++i) {
                float* pp = part + wave * 2048 + q * 1024 + lane * 16 + i * 4;
                *(float4*)(pp) = make_float4(acc[q * 8 + i * 2][0], acc[q * 8 + i * 2][1], acc[q * 8 + i * 2 + 1][0], acc[q * 8 + i * 2 + 1][1]);
            }
        lds_barrier();
        float rr[8];
        {
            rr[0] = DN_ALPHA * xres0[0]; rr[1] = DN_ALPHA * xres0[1]; rr[2] = DN_ALPHA * xres0[2]; rr[3] = DN_ALPHA * xres0[3];
            rr[4] = DN_ALPHA * xres1[0]; rr[5] = DN_ALPHA * xres1[1]; rr[6] = DN_ALPHA * xres1[2]; rr[7] = DN_ALPHA * xres1[3];
#pragma unroll
            for (int w = 0; w < 4; ++w) {
                const float4 a = *(const float4*)(part + w * 2048 + tid * 8), bq = *(const float4*)(part + w * 2048 + tid * 8 + 4);
                rr[0] += a.x; rr[1] += a.y; rr[2] += a.z; rr[3] += a.w; rr[4] += bq.x; rr[5] += bq.y; rr[6] += bq.z; rr[7] += bq.w;
            }
        }
        float s = 0.f;
#pragma unroll
        for (int j = 0; j < 8; ++j) s += rr[j];
        s = wsum(s);
        if (lane == 0) red[wave] = s;
        lds_barrier();
        const float mu = (red[0] + red[1] + red[2] + red[3]) * (1.f / DM);
        float qv = 0.f;
#pragma unroll
        for (int j = 0; j < 8; ++j) { rr[j] -= mu; qv += rr[j] * rr[j]; }
        qv = wsum(qv);
        if (lane == 0) red[4 + wave] = qv;
        lds_barrier();
        const float rs = rsqrtf((red[4] + red[5] + red[6] + red[7]) * (1.f / DM) + LN_EPS);
        float* op = p.out + (size_t)tok * DM + tid * 8;
        *(float4*)(op) = make_float4(rr[0] * rs * l3g0[0] + l3b0[0], rr[1] * rs * l3g0[1] + l3b0[1], rr[2] * rs * l3g0[2] + l3b0[2], rr[3] * rs * l3g0[3] + l3b0[3]);
        *(float4*)(op + 4) = make_float4(rr[4] * rs * l3g1[0] + l3b1[0], rr[5] * rs * l3g1[1] + l3b1[1], rr[6] * rs * l3g1[2] + l3b1[2], rr[7] * rs * l3g1[3] + l3b1[3]);
        tok = nxt[(it + 1) & 1];
    }
}

__device__ __forceinline__ void run_phase(int ph, const Params& p, unsigned char* smem, const int vbid) {
    unsigned char* ws = p.ws;
    switch (ph) {
    case 0: phase0(p, smem); break;
    case 1: phase1(p, smem, vbid); break;
    case 2: phase2(p, smem); break;
    case 3: phase3(p); break;
    case 4:
        for (int it = blockIdx.x; it < 1024; it += gridDim.x) hgrn_c_item(p, it, smem);
        break;
    case 5: {
        float* R1 = (float*)(ws + OFF_RD);
        FOR_TILES_XCD_BIG(16, m, n) {
            const int tile = m * 16 + n;
            const u16* A = (const u16*)(ws + OFF_RC) + (size_t)m * 256 * DM;
            const u16* Bt = (const u16*)(ws + OFF_WT_OUT) + (size_t)n * 128 * DM;
            const float* xr = p.x + (size_t)m * 256 * DM + n * 128;
            float* o = R1 + (size_t)m * 256 * DM + n * 128;
            gemm_tile_big(A, DM, Bt, DM, DM, smem, [&](int r, int c, f32x4 v) { *(f32x4*)(o + (size_t)r * DM + c) = v; }, xr, DM, DN_ALPHA);
            cvt_fp8_rows(p.peer_u, ws + OFF_UB, (float*)(ws + OFF_SU), tile * 32, tile * 32 + 32);
        }
    } break;
    case 6:
        ln_rows((const float*)(ws + OFF_RD), p.ln1_g, p.ln1_b, (float*)(ws + OFF_RE), (u16*)(ws + OFF_RC));
        break;
    case 7: {
        float* SC = (float*)(ws + OFF_SC);
        FOR_TILES_XCD(8, m, n) {
            const int b = m >> 5;
            const u16* A = (const u16*)(ws + OFF_RC) + (size_t)m * 128 * DM;
            const u16* Bt = (const u16*)(ws + OFF_WQKT) + (size_t)b * 1024 * DM + (size_t)n * 128 * DM;
            float* o = SC + (size_t)m * 128 * 1024 + n * 128;
            gemm_tile(A, DM, Bt, DM, DM, smem, [&](int r, int c, f32x4 v) { *(f32x4*)(o + (size_t)r * 1024 + c) = v; });
        }
    } break;
    case 8:
        phase8(p);
        break;
    case 9: {
        float* R2 = (float*)(ws + OFF_RD);
        const float* X1 = (const float*)(ws + OFF_RE);
        FOR_TILES_XCD_BIG(16, m, n) {
            const int tile = m * 16 + n;
            const int b = m >> 4;
            const u16* A = (const u16*)(ws + OFF_PB) + (size_t)m * 256 * 1024;
            const u16* Bt = (const u16*)(ws + OFF_WVOT) + (size_t)b * 2048 * 1024 + (size_t)n * 128 * 1024;
            const float* xr = X1 + (size_t)m * 256 * DM + n * 128;
            float* o = R2 + (size_t)m * 256 * DM + n * 128;
            gemm_tile_big(A, 1024, Bt, 1024, 1024, smem, [&](int r, int c, f32x4 v) { *(f32x4*)(o + (size_t)r * DM + c) = v; }, xr, DM, DN_ALPHA);
            cvt_fp8_rows(p.peer_v, ws + OFF_VB, (float*)(ws + OFF_SV), tile * 32, tile * 32 + 32);
        }
    } break;
    case 10:
        ln_rows((const float*)(ws + OFF_RD), p.ln2_g, p.ln2_b, (float*)(ws + OFF_RE), (u16*)(ws + OFF_RC));
        break;
    case 11: {
        float* PS = (float*)(ws + OFF_RD);
        FOR_TILES_XCD_BIG(16, m, n) {
            const u16* A = (const u16*)(ws + OFF_RC) + (size_t)m * 256 * DM;
            const u16* Bt = (const u16*)(ws + OFF_WSKT) + (size_t)n * 128 * DM;
            float* o = PS + (size_t)m * 256 * DM + n * 128;
            gemm_tile_big(A, DM, Bt, DM, DM, smem, [&](int r, int c, f32x4 v) { *(f32x4*)(o + (size_t)r * DM + c) = v; });
        }
    } break;
    case 12: phase12(p, smem); break;
    default: break;
    }
}

__global__ void __launch_bounds__(256, 2) fwd_kernel(Params p) {
    __shared__ __attribute__((aligned(16))) unsigned char smem_raw[SMEM_BYTES + 16];
    unsigned char* smem = smem_raw + 16;
    const bool multi = (p.ph_hi - p.ph_lo) > 1;
    XcdBarrier bar;
    if (multi) {
        if (threadIdx.x == 0) *(uint4*)smem_raw = make_uint4(0u, 0u, 0u, 0u);
        __syncthreads();
        bar = xcd_barrier_post((unsigned*)(p.ws + OFF_BAR), (volatile LAS unsigned*)smem_raw);
    }
    int vbid = blockIdx.x;
    for (int ph = p.ph_lo; ph < p.ph_hi; ++ph) {
        run_phase(ph, p, smem, vbid);
        if (ph + 1 < p.ph_hi) {
            xcd_barrier(bar);
            if (ph == p.ph_lo) {
                if (threadIdx.x == 0) {
                    unsigned* bw = (unsigned*)(p.ws + OFF_BAR);
                    const unsigned per = gridDim.x >> 3;
                    bool ok = (gridDim.x & 7u) == 0u;
                    for (unsigned j = 0; j < 16; ++j) { const unsigned c = xb_ld(&bw[XB_XCNT(j)]); ok = ok && (c == (j < 8 ? per : 0u)); }
                    const unsigned tk = bar.st[2];
                    bar.st[3] = (ok && tk < per && bar.x < 8u) ? (tk * 8u + bar.x) : blockIdx.x;
                }
                __syncthreads();
                vbid = (int)bar.st[3];
                __syncthreads();
            }
        }
    }
}

extern "C" void kernel_launch(void* const* d_in, const int* in_sizes, int n_in, void* d_out, int out_size,
                              void* d_ws, size_t ws_size, hipStream_t stream) {
    static int grid = 0;
    if (grid == 0) {
        if (n_in != 25 || ws_size < OFF_END) { fprintf(stderr, "kernel_launch: unexpected n_in %d or ws_size %zu (< %zu)\n", n_in, ws_size, (size_t)OFF_END); grid = -1; return; }
        int dev = 0, cus = 0, per_cu = 0;
        hipGetDevice(&dev);
        hipDeviceGetAttribute(&cus, hipDeviceAttributeMultiprocessorCount, dev);
        hipOccupancyMaxActiveBlocksPerMultiprocessor(&per_cu, (const void*)fwd_kernel, 256, 0);
        if (per_cu > 2) per_cu = 2;
        if (per_cu < 1) per_cu = 1;
        grid = cus * per_cu;
    }
    if (grid < 0) return;
    Params p{};
    const float** pp = (const float**)&p;
    for (int i = 0; i < 25; ++i) pp[i] = (const float*)d_in[i];
    p.out = (float*)d_out;
    p.ws = (unsigned char*)d_ws;
#if ONE_LAUNCH
    hipMemsetAsync((unsigned char*)d_ws + OFF_BAR, 0, 16384, stream);
    p.ph_lo = 0; p.ph_hi = NPHASE;
    void* args[] = {&p};
    hipError_t e = hipLaunchCooperativeKernel((const void*)fwd_kernel, dim3(grid), dim3(256), args, 0, stream);
    if (e != hipSuccess) fprintf(stderr, "cooperative launch failed: %s (grid %d)\n", hipGetErrorString(e), grid);
#else
    for (int ph = 0; ph < NPHASE; ++ph) {
        p.ph_lo = ph; p.ph_hi = ph + 1;
        hipLaunchKernelGGL(fwd_kernel, dim3(grid), dim3(256), 0, stream, p);
    }
#endif
}
```

```cpp
#include <hip/hip_runtime.h>
#include <stdint.h>
#include <stdio.h>

#ifndef ONE_LAUNCH
#define ONE_LAUNCH 1
#endif

typedef unsigned short u16;
using bf16x8 = __attribute__((ext_vector_type(8))) short;
using f32x16 = __attribute__((ext_vector_type(16))) float;
using f32x2 = __attribute__((ext_vector_type(2))) float;
using f32x4 = __attribute__((ext_vector_type(4))) float;
using u32x4 = __attribute__((ext_vector_type(4))) unsigned int;

#define NTOK 8192
#define DM 2048
#define SEQ 4096
#define NPHASE 13
#define LN_EPS 1e-5f
#define DN_ALPHA 1.189207115002721f

constexpr size_t SZ_DD = (size_t)2048 * 2048 * 2;
constexpr size_t OFF_WT_IN = 0;
constexpr size_t OFF_WT_OUT = OFF_WT_IN + (size_t)6144 * 2048 * 2;
constexpr size_t OFF_WQ_B = OFF_WT_OUT + SZ_DD;
constexpr size_t OFF_WT_K = OFF_WQ_B + SZ_DD;
constexpr size_t OFF_WT_V = OFF_WT_K + SZ_DD;
constexpr size_t OFF_WT_O = OFF_WT_V + SZ_DD;
constexpr size_t OFF_PWQ_B = OFF_WT_O + SZ_DD;
constexpr size_t OFF_WQKT = OFF_PWQ_B + SZ_DD;
constexpr size_t OFF_WVOT = OFF_WQKT + SZ_DD;
constexpr size_t OFF_WSKT = OFF_WVOT + SZ_DD;
constexpr size_t OFF_MEMB = OFF_WSKT + SZ_DD;
constexpr size_t OFF_KP = OFF_MEMB + (size_t)512 * 2048 * 2;
constexpr size_t OFF_VP = OFF_KP + (size_t)512 * 2048 * 2;
constexpr size_t OFF_K1B = OFF_VP + (size_t)512 * 2048 * 2;
constexpr size_t OFF_K2B = OFF_K1B + 32768;
constexpr size_t OFF_DEC = OFF_K2B + 32768;
constexpr size_t OFF_BAR = OFF_DEC + (size_t)1024 * 128 * 4;
constexpr size_t OFF_RC = OFF_BAR + 16384;
constexpr size_t OFF_RD = OFF_RC + (size_t)NTOK * DM * 2;
constexpr size_t OFF_RE = OFF_RD + (size_t)NTOK * DM * 4;
constexpr size_t OFF_RA = OFF_RE + (size_t)NTOK * DM * 4;
constexpr size_t SZ_SEG = (size_t)NTOK * 1024 * 2;
constexpr size_t OFF_UA = OFF_RA;
constexpr size_t OFF_VA = OFF_UA + SZ_SEG;
constexpr size_t OFF_QB = OFF_VA + SZ_SEG;
constexpr size_t OFF_IB = OFF_QB + SZ_SEG;
constexpr size_t OFF_GB = OFF_IB + SZ_SEG;
constexpr size_t OFF_LF = OFF_GB + SZ_SEG;
constexpr size_t OFF_RB = OFF_LF + (size_t)NTOK * 1024 * 4;
constexpr size_t OFF_UT = OFF_RB;
constexpr size_t OFF_ST = OFF_UT + (size_t)1024 * 16384 * 4;
constexpr size_t OFF_END = OFF_ST + (size_t)1024 * 16384 * 2;
constexpr size_t OFF_UB = OFF_RA;
constexpr size_t OFF_VB = OFF_UB + (size_t)16384 * 2048;
constexpr size_t OFF_SU = OFF_VB + (size_t)16384 * 2048;
constexpr size_t OFF_SV = OFF_SU + 65536;
constexpr size_t OFF_SC = OFF_RB + (size_t)48 * 1048576;
constexpr size_t OFF_PB = OFF_RB + (size_t)80 * 1048576;
static_assert(OFF_SV + 65536 <= OFF_SC, "alias overlap");
static_assert(OFF_PB + (size_t)NTOK * 1024 * 2 <= OFF_END, "alias overflow");

#define SMEM_BYTES 74240

struct Params {
    const float* x; const float* mem; const float* w_in; const float* sgu_w; const float* sgu_b;
    const float* sgu_ln_g; const float* sgu_ln_b; const float* lb_logits; const float* hgrn_g;
    const float* w_out; const float* ln1_g; const float* ln1_b; const float* xa_wq; const float* xa_wk;
    const float* xa_wv; const float* xa_wo; const float* ln2_g; const float* ln2_b; const float* peer_wq;
    const float* peer_k1; const float* peer_k2; const float* peer_u; const float* peer_v;
    const float* ln3_g; const float* ln3_b;
    float* out; unsigned char* ws;
    int ph_lo; int ph_hi;
};

typedef __bf16 bf16x2_t __attribute__((ext_vector_type(2)));
__device__ __forceinline__ u16 f2bf(float f) { return __builtin_bit_cast(u16, (__bf16)f); }
__device__ __forceinline__ float bf2f(u16 h) { return __uint_as_float(((uint32_t)h) << 16); }
__device__ __forceinline__ uint32_t pack2(float a, float b) {
    f32x2 v = {a, b};
    return __builtin_bit_cast(uint32_t, __builtin_convertvector(v, bf16x2_t));
}
__device__ __forceinline__ void st_bf4(u16* p, f32x4 v) { *(uint2*)p = make_uint2(pack2(v[0], v[1]), pack2(v[2], v[3])); }
__device__ __forceinline__ float bflo(uint32_t w) { return __uint_as_float(w << 16); }
__device__ __forceinline__ float bfhi(uint32_t w) { return __uint_as_float(w & 0xffff0000u); }
__device__ __forceinline__ float gelu_t(float x) {
    float u = 0.7978845608028654f * (x + 0.044715f * x * x * x);
    return x * __builtin_amdgcn_rcpf(1.f + __expf(-2.f * u));
}
__device__ __forceinline__ float sigmoid_f(float x) { return __builtin_amdgcn_rcpf(1.f + __expf(-x)); }
__device__ __forceinline__ unsigned sort_key(float v) {
    const unsigned b = __float_as_uint(v);
    return (b & 0x80000000u) ? ~b : (b | 0x80000000u);
}
__device__ __forceinline__ float wsum(float v) {
#pragma unroll
    for (int o = 32; o > 0; o >>= 1) v += __shfl_xor(v, o);
    return v;
}

__device__ __forceinline__ void lds_barrier() {
    asm volatile("s_waitcnt lgkmcnt(0)" ::: "memory");
    __builtin_amdgcn_s_barrier();
    asm volatile("" ::: "memory");
}
__device__ __forceinline__ int opaque_tid() { int t = threadIdx.x; asm volatile("" : "+v"(t)); return t; }

#define XB_TMO      128
#define XB_XCNT(j)  (256  + 64 * (j))
#define XB_XSUB(j)  (1280 + 64 * (j))
#define XB_XGEN(j)  (2304 + 64 * (j))
#define XB_TOP      3328
#define XB_TOPGEN   3392
#define XCD_BAR_WORDS 3456
#define XB_SPIN_CAP (1u << 22)
#define LAS __attribute__((address_space(3)))
__device__ __forceinline__ unsigned xb_ld(unsigned* p) { return __hip_atomic_load(p, __ATOMIC_RELAXED, __HIP_MEMORY_SCOPE_AGENT); }
__device__ __forceinline__ unsigned xb_add(unsigned* p, unsigned v) { return __hip_atomic_fetch_add(p, v, __ATOMIC_RELAXED, __HIP_MEMORY_SCOPE_AGENT); }
__device__ __forceinline__ unsigned xb_xcc_id() { return (unsigned)__builtin_amdgcn_s_getreg((3 << 11) | 20) & 0xFu; }
#define XB_SPIN(cond, bar) do { unsigned _sp = 0; while (cond) { __builtin_amdgcn_s_sleep(1); \
    if ((++_sp & 255u) == 0u) { if (xb_ld(&(bar)[XB_TMO])) break; if (_sp > XB_SPIN_CAP) { atomicAdd(&(bar)[XB_TMO], 1u); break; } } } } while (0)
struct XcdBarrier { unsigned* bar; unsigned x; volatile LAS unsigned* st; };
__device__ __forceinline__ XcdBarrier xcd_barrier_post(unsigned* bar, volatile LAS unsigned* st) {
    XcdBarrier b; b.bar = bar; b.x = xb_xcc_id(); b.st = st;
    if (threadIdx.x == 0) st[2] = xb_add(&bar[XB_XCNT(b.x)], 1u);
    return b;
}
__device__ __forceinline__ void xcd_barrier_complete(unsigned* bar, unsigned x, unsigned& nloc, unsigned& nx) {
    const unsigned G = gridDim.x * gridDim.y * gridDim.z;
    unsigned sum, cnt, mine, sp = 0u;
    for (;;) {
        sum = 0u; cnt = 0u; mine = 0u;
#pragma unroll
        for (unsigned j = 0; j < 16; ++j) { const unsigned c = xb_ld(&bar[XB_XCNT(j)]); sum += c; cnt += (c > 0u) ? 1u : 0u; mine = (j == x) ? c : mine; }
        if (sum == G) break;
        __builtin_amdgcn_s_sleep(1);
        if ((++sp & 255u) == 0u) { if (xb_ld(&bar[XB_TMO])) break; if (sp > XB_SPIN_CAP) { atomicAdd(&bar[XB_TMO], 1u); break; } }
    }
    nloc = mine > 0u ? mine : 1u; nx = cnt > 0u ? cnt : 1u;
}
__device__ __forceinline__ void xcd_barrier(const XcdBarrier& b) {
    asm volatile("s_waitcnt vmcnt(0)" ::: "memory");
    __syncthreads();
    if (threadIdx.x == 0) {
        unsigned* bar = b.bar;
        __builtin_amdgcn_s_waitcnt(0);
        unsigned nloc = b.st[0], nx = b.st[1];
        if (nloc == 0u) { xcd_barrier_complete(bar, b.x, nloc, nx); b.st[0] = nloc; b.st[1] = nx; }
        const unsigned old = xb_add(&bar[XB_XSUB(b.x)], 1u);
        const unsigned gen = old / nloc;
        if (old + 1u == (gen + 1u) * nloc) {
            __builtin_amdgcn_fence(__ATOMIC_RELEASE, "agent");
            asm volatile("s_waitcnt vmcnt(0)" ::: "memory");
            const unsigned og = xb_add(&bar[XB_TOP], 1u);
            const unsigned tg = og / nx;
            if (og + 1u == (tg + 1u) * nx) xb_add(&bar[XB_TOPGEN], 1u);
            else XB_SPIN(xb_ld(&bar[XB_TOPGEN]) == tg, bar);
            __builtin_amdgcn_fence(__ATOMIC_ACQUIRE, "agent");
            xb_add(&bar[XB_XGEN(b.x)], 1u);
            asm volatile("s_waitcnt vmcnt(0)" ::: "memory");
        } else {
            XB_SPIN(xb_ld(&bar[XB_XGEN(b.x)]) == gen, bar);
            __builtin_amdgcn_fence(__ATOMIC_ACQUIRE, "agent");
            asm volatile("s_waitcnt vmcnt(0)" ::: "memory");
        }
    }
    __syncthreads();
}

template <class Epi>
__device__ __forceinline__ void gemm_tile(const u16* __restrict__ A, int lda, const u16* __restrict__ Bt, int ldb, int K,
                                          unsigned char* smem, Epi epi) {
    const int tid = opaque_tid(), lane = tid & 63, wave = tid >> 6;
    const int wm = wave >> 1, wn = wave & 1;
    f32x16 acc[2][2];
#pragma unroll
    for (int i = 0; i < 2; ++i)
#pragma unroll
        for (int j = 0; j < 2; ++j)
#pragma unroll
            for (int r = 0; r < 16; ++r) acc[i][j][r] = 0.f;
    const int lr = wave * 32 + (lane >> 3);
    const int lc = lane & 7;
    const u16* gA[4]; const u16* gB[4];
#pragma unroll
    for (int i = 0; i < 4; ++i) {
        const int row = lr + 8 * i;
        const int ch = lc ^ ((row >> 1) & 7);
        gA[i] = A + (size_t)row * lda + ch * 8;
        gB[i] = Bt + (size_t)row * ldb + ch * 8;
    }
    unsigned char* sbase = smem + wave * 4096;
    auto glds = [&](int k0, int buf) {
        unsigned char* dA = sbase + buf * 32768;
        unsigned char* dB = dA + 16384;
#pragma unroll
        for (int i = 0; i < 4; ++i) {
            __builtin_amdgcn_global_load_lds((const unsigned*)(gA[i] + k0), (__attribute__((address_space(3))) unsigned*)(dA + i * 1024), 16, 0, 0);
            __builtin_amdgcn_global_load_lds((const unsigned*)(gB[i] + k0), (__attribute__((address_space(3))) unsigned*)(dB + i * 1024), 16, 0, 0);
        }
    };
    int offA[2], offB[2], swA[2], swB[2];
#pragma unroll
    for (int i = 0; i < 2; ++i) {
        const int ra = wm * 64 + i * 32 + (lane & 31), rb = wn * 64 + i * 32 + (lane & 31);
        offA[i] = ra * 128; swA[i] = (ra >> 1) & 7;
        offB[i] = rb * 128; swB[i] = (rb >> 1) & 7;
    }
    const int half = lane >> 5;
    lds_barrier();
    glds(0, 0);
    asm volatile("s_waitcnt vmcnt(0)" ::: "memory");
    __syncthreads();
    const int nk = K >> 6;
    for (int kt = 0; kt < nk; ++kt) {
        const int buf = kt & 1;
        const int kn = ((kt + 1 < nk) ? (kt + 1) : kt) * 64;
        unsigned char* dA = sbase + (buf ^ 1) * 32768;
        unsigned char* dB = dA + 16384;
        const unsigned char* bA = smem + buf * 32768;
        const unsigned char* bB = bA + 16384;
#pragma unroll
        for (int ks = 0; ks < 4; ++ks) {
            bf16x8 af[2], bf[2];
            const int kc = ks * 2 + half;
#pragma unroll
            for (int i = 0; i < 2; ++i) af[i] = *(const bf16x8*)(bA + offA[i] + ((kc ^ swA[i]) << 4));
#pragma unroll
            for (int j = 0; j < 2; ++j) bf[j] = *(const bf16x8*)(bB + offB[j] + ((kc ^ swB[j]) << 4));
#pragma unroll
            for (int i = 0; i < 2; ++i)
#pragma unroll
                for (int j = 0; j < 2; ++j)
                    acc[i][j] = __builtin_amdgcn_mfma_f32_32x32x16_bf16(bf[j], af[i], acc[i][j], 0, 0, 0);
            __builtin_amdgcn_global_load_lds((const unsigned*)(gA[ks] + kn), (__attribute__((address_space(3))) unsigned*)(dA + ks * 1024), 16, 0, 0);
            __builtin_amdgcn_global_load_lds((const unsigned*)(gB[ks] + kn), (__attribute__((address_space(3))) unsigned*)(dB + ks * 1024), 16, 0, 0);
        }
        asm volatile("s_waitcnt vmcnt(0)" ::: "memory");
        __syncthreads();
    }
#pragma unroll
    for (int i = 0; i < 2; ++i)
#pragma unroll
        for (int j = 0; j < 2; ++j)
#pragma unroll
            for (int g = 0; g < 4; ++g) {
                const int row = wm * 64 + i * 32 + (lane & 31);
                const int col = wn * 64 + j * 32 + 8 * g + 4 * (lane >> 5);
                const f32x4 v = {acc[i][j][4 * g], acc[i][j][4 * g + 1], acc[i][j][4 * g + 2], acc[i][j][4 * g + 3]};
                epi(row, col, v);
            }
}

#define FOR_TILES_XCD(NT, m, n)                                                                   \
    for (int _t = (int)(vbid >> 3), _x = (int)(vbid & 7), _np = (int)(gridDim.x >> 3), \
             m = 0, n = 0;                                                                         \
         (_t < 8 * (NT)) && ((m = 8 * _x + ((_t & 63) >> 3)), (n = ((_t >> 6) << 3) + (_t & 7)), true); _t += _np)

template <class Epi>
__device__ __forceinline__ void gemm_tile_big(const u16* __restrict__ A, int lda, const u16* __restrict__ Bt, int ldb, int K,
                                              unsigned char* smem, Epi epi, const float* __restrict__ res = nullptr, int ldres = 0, float alpha = 0.f) {
    const int tid = opaque_tid(), lane = tid & 63, wave = tid >> 6;
    const int wm = wave >> 1, wn = wave & 1;
    f32x16 acc[4][2];
    if (res) {
#pragma unroll
        for (int i = 0; i < 4; ++i)
#pragma unroll
            for (int j = 0; j < 2; ++j)
#pragma unroll
                for (int g = 0; g < 4; ++g) {
                    const int row = wm * 128 + i * 32 + (lane & 31);
                    const int col = wn * 64 + j * 32 + 8 * g + 4 * (lane >> 5);
                    const f32x4 x = *(const f32x4*)(res + (size_t)row * ldres + col);
                    acc[i][j][4 * g] = alpha * x[0]; acc[i][j][4 * g + 1] = alpha * x[1];
                    acc[i][j][4 * g + 2] = alpha * x[2]; acc[i][j][4 * g + 3] = alpha * x[3];
                }
    } else {
#pragma unroll
        for (int i = 0; i < 4; ++i)
#pragma unroll
            for (int j = 0; j < 2; ++j)
#pragma unroll
                for (int r = 0; r < 16; ++r) acc[i][j][r] = 0.f;
    }
    const u16* gA[4]; const u16* gB[2];
#pragma unroll
    for (int i = 0; i < 4; ++i) {
        const int row = wave * 64 + i * 16 + (lane >> 2);
        gA[i] = A + (size_t)row * lda + (((lane & 3) ^ ((row >> 2) & 3)) << 3);
    }
#pragma unroll
    for (int i = 0; i < 2; ++i) {
        const int row = wave * 32 + i * 16 + (lane >> 2);
        gB[i] = Bt + (size_t)row * ldb + (((lane & 3) ^ ((row >> 2) & 3)) << 3);
    }
    auto glds = [&](int k0, int st) {
        unsigned char* dA = smem + st * 24576 + wave * 4096;
        unsigned char* dB = smem + st * 24576 + 16384 + wave * 2048;
#pragma unroll
        for (int i = 0; i < 4; ++i)
            __builtin_amdgcn_global_load_lds((const unsigned*)(gA[i] + k0), (__attribute__((address_space(3))) unsigned*)(dA + i * 1024), 16, 0, 0);
#pragma unroll
        for (int i = 0; i < 2; ++i)
            __builtin_amdgcn_global_load_lds((const unsigned*)(gB[i] + k0), (__attribute__((address_space(3))) unsigned*)(dB + i * 1024), 16, 0, 0);
    };
    int offA[4], swA[4], offB[2], swB[2];
#pragma unroll
    for (int i = 0; i < 4; ++i) { const int ra = wm * 128 + i * 32 + (lane & 31); offA[i] = ra * 64; swA[i] = (ra >> 2) & 3; }
#pragma unroll
    for (int j = 0; j < 2; ++j) { const int rb = wn * 64 + j * 32 + (lane & 31); offB[j] = 16384 + rb * 64; swB[j] = (rb >> 2) & 3; }
    const int half = lane >> 5;
    const int nk = K >> 5;
    lds_barrier();
    glds(0, 0);
    glds(32, 1);
    int st = 0;
    for (int kt = 0; kt < nk; ++kt) {
        asm volatile("s_waitcnt vmcnt(6)\n\ts_waitcnt lgkmcnt(0)" ::: "memory");
        __builtin_amdgcn_s_barrier();
        const int kn = ((kt + 2 < nk) ? (kt + 2) : (nk - 1)) * 32;
        const int sn = (st >= 1) ? (st - 1) : 2;
        unsigned char* dA = smem + sn * 24576 + wave * 4096;
        unsigned char* dB = smem + sn * 24576 + 16384 + wave * 2048;
        const unsigned char* bS = smem + st * 24576;
#pragma unroll
        for (int ks = 0; ks < 2; ++ks) {
            bf16x8 af[4], bf[2];
            const int kc = ks * 2 + half;
#pragma unroll
            for (int i = 0; i < 4; ++i) af[i] = *(const bf16x8*)(bS + offA[i] + ((kc ^ swA[i]) << 4));
#pragma unroll
            for (int j = 0; j < 2; ++j) bf[j] = *(const bf16x8*)(bS + offB[j] + ((kc ^ swB[j]) << 4));
#pragma unroll
            for (int i = 0; i < 4; ++i)
#pragma unroll
                for (int j = 0; j < 2; ++j)
                    acc[i][j] = __builtin_amdgcn_mfma_f32_32x32x16_bf16(bf[j], af[i], acc[i][j], 0, 0, 0);
            if (ks == 0) {
#pragma unroll
                for (int i = 0; i < 3; ++i)
                    __builtin_amdgcn_global_load_lds((const unsigned*)(gA[i] + kn), (__attribute__((address_space(3))) unsigned*)(dA + i * 1024), 16, 0, 0);
            } else {
                __builtin_amdgcn_global_load_lds((const unsigned*)(gA[3] + kn), (__attribute__((address_space(3))) unsigned*)(dA + 3 * 1024), 16, 0, 0);
#pragma unroll
                for (int i = 0; i < 2; ++i)
                    __builtin_amdgcn_global_load_lds((const unsigned*)(gB[i] + kn), (__attribute__((address_space(3))) unsigned*)(dB + i * 1024), 16, 0, 0);
            }
        }
        st = (st == 2) ? 0 : (st + 1);
    }
    asm volatile("s_waitcnt vmcnt(0)" ::: "memory");
    lds_barrier();
    float* stg = (float*)(smem + wave * 8704);
#pragma unroll
    for (int i = 0; i < 4; ++i) {
#pragma unroll
        for (int j = 0; j < 2; ++j)
#pragma unroll
            for (int g = 0; g < 4; ++g)
                *(f32x4*)(stg + (lane & 31) * 68 + j * 32 + 8 * g + 4 * (lane >> 5)) =
                    f32x4{acc[i][j][4 * g], acc[i][j][4 * g + 1], acc[i][j][4 * g + 2], acc[i][j][4 * g + 3]};
        asm volatile("s_waitcnt lgkmcnt(0)" ::: "memory");
#pragma unroll
        for (int rr = 0; rr < 8; ++rr) {
            const int r = rr * 4 + (lane >> 4), c4 = (lane & 15) * 4;
            const f32x4 v = *(const f32x4*)(stg + r * 68 + c4);
            epi(wm * 128 + i * 32 + r, wn * 64 + c4, v);
        }
        asm volatile("s_waitcnt lgkmcnt(0)" ::: "memory");
    }
}

#define FOR_TILES_XCD_BIG(NT, m, n)                                                               \
    for (int _t = (int)(vbid >> 3), _x = (int)(vbid & 7), _np = (int)(gridDim.x >> 3), \
             m = 0, n = 0;                                                                         \
         (_t < 4 * (NT)) && ((m = 4 * _x + ((_t & 31) >> 3)), (n = ((_t >> 5) << 3) + (_t & 7)), true); _t += _np)


__device__ __forceinline__ bf16x8 ld_frag_strided(const u16* p, int stride) {
    bf16x8 f;
#pragma unroll
    for (int j = 0; j < 8; ++j) f[j] = (short)p[j * stride];
    return f;
}

__device__ __forceinline__ void cvt_job(const float* __restrict__ src, u16* __restrict__ dst, size_t n, int bid, int nb) {
    const size_t nchunk = n / 8;
    const int tid = opaque_tid();
    const size_t S = (size_t)nb * 256;
    for (size_t c = (size_t)bid * 256 + tid; c < nchunk; c += 4 * S) {
        f32x4 a[4], b[4];
#pragma unroll
        for (int u = 0; u < 4; ++u) {
            const size_t cc = c + u * S;
            if (cc < nchunk) { a[u] = *(const f32x4*)(src + cc * 8); b[u] = *(const f32x4*)(src + cc * 8 + 4); }
        }
#pragma unroll
        for (int u = 0; u < 4; ++u) {
            const size_t cc = c + u * S;
            if (cc < nchunk) {
                u32x4 o;
                o[0] = pack2(a[u][0], a[u][1]); o[1] = pack2(a[u][2], a[u][3]); o[2] = pack2(b[u][0], b[u][1]); o[3] = pack2(b[u][2], b[u][3]);
                *(u32x4*)(dst + cc * 8) = o;
            }
        }
    }
}
__device__ __forceinline__ void cvt_fp8_rows(const float* __restrict__ src, unsigned char* __restrict__ dst, float* __restrict__ scl, int row_begin, int row_end) {
    const int tid = opaque_tid(); const int lane = tid & 63, wave = tid >> 6;
    for (int row0 = row_begin + wave * 2; row0 < row_end; row0 += 8) {
        float4 v[2][8];
#pragma unroll
        for (int rr = 0; rr < 2; ++rr)
#pragma unroll
            for (int q = 0; q < 2; ++q)
#pragma unroll
                for (int i = 0; i < 4; ++i)
                    v[rr][q * 4 + i] = *(const float4*)(src + (size_t)(row0 + rr) * 2048 + q * 1024 + lane * 16 + i * 4);
#pragma unroll
        for (int rr = 0; rr < 2; ++rr) {
            const int row = row0 + rr;
            float am = 0.f;
#pragma unroll
            for (int i = 0; i < 8; ++i)
                am = fmaxf(am, fmaxf(fmaxf(fabsf(v[rr][i].x), fabsf(v[rr][i].y)), fmaxf(fabsf(v[rr][i].z), fabsf(v[rr][i].w))));
#pragma unroll
            for (int o = 32; o > 0; o >>= 1) am = fmaxf(am, __shfl_xor(am, o));
            const float sc = am > 0.f ? 240.f / am : 1.f;
            if (lane == 0) scl[row] = am > 0.f ? am * (1.f / 240.f) : 1.f;
#pragma unroll
            for (int q = 0; q < 2; ++q) {
                u32x4 o;
#pragma unroll
                for (int i = 0; i < 4; ++i) {
                    int w = 0;
                    w = __builtin_amdgcn_cvt_pk_fp8_f32(v[rr][q * 4 + i].x * sc, v[rr][q * 4 + i].y * sc, w, false);
                    w = __builtin_amdgcn_cvt_pk_fp8_f32(v[rr][q * 4 + i].z * sc, v[rr][q * 4 + i].w * sc, w, true);
                    o[i] = (unsigned)w;
                }
                *(u32x4*)(dst + (size_t)row * 2048 + q * 1024 + lane * 16) = o;
            }
        }
    }
}
__device__ __forceinline__ void transpose_job(const float* __restrict__ W, u16* __restrict__ Wt, int Kd, int Nd, unsigned char* smem, int bid, int nb) {
    float* t = (float*)smem;
    const int tid = opaque_tid();
    const int tk = Kd / 64, tn = Nd / 64, nt = tk * tn;
    const int lk = tid >> 4, n4 = (tid & 15) * 4;
    f32x4 v[2][4];
#pragma unroll
    for (int u = 0; u < 2; ++u) {
        const int tile = bid + u * nb;
        if (tile < nt) {
            const int k0 = (tile / tn) * 64, n0 = (tile % tn) * 64;
#pragma unroll
            for (int i = 0; i < 4; ++i) v[u][i] = *(const f32x4*)(W + (size_t)(k0 + lk + 16 * i) * Nd + n0 + n4);
        }
    }
    for (int tile0 = bid; tile0 < nt; tile0 += 2 * nb) {
        lds_barrier();
#pragma unroll
        for (int u = 0; u < 2; ++u)
#pragma unroll
            for (int i = 0; i < 4; ++i) {
                float* tp = t + u * (64 * 65) + (lk + 16 * i) * 65 + n4;
                tp[0] = v[u][i][0]; tp[1] = v[u][i][1]; tp[2] = v[u][i][2]; tp[3] = v[u][i][3];
            }
        lds_barrier();
#pragma unroll
        for (int u = 0; u < 2; ++u) {
            const int nxt = tile0 + (2 + u) * nb;
            if (nxt < nt) {
                const int k1 = (nxt / tn) * 64, n1 = (nxt % tn) * 64;
#pragma unroll
                for (int i = 0; i < 4; ++i) v[u][i] = *(const f32x4*)(W + (size_t)(k1 + lk + 16 * i) * Nd + n1 + n4);
            }
        }
#pragma unroll
        for (int u = 0; u < 2; ++u) {
            const int tile = tile0 + u * nb;
            if (tile < nt) {
                const int k0 = (tile / tn) * 64, n0 = (tile % tn) * 64;
                const float* tb = t + u * (64 * 65);
                const int n = tid >> 2, kq = (tid & 3) * 16;
                uint32_t o[8];
#pragma unroll
                for (int j = 0; j < 8; ++j) o[j] = pack2(tb[(kq + 2 * j) * 65 + n], tb[(kq + 2 * j + 1) * 65 + n]);
                u32x4* dp = (u32x4*)(Wt + (size_t)(n0 + n) * Kd + k0 + kq);
                dp[0] = u32x4{o[0], o[1], o[2], o[3]};
                dp[1] = u32x4{o[4], o[5], o[6], o[7]};
            }
        }
    }
}

__device__ __forceinline__ void ln_rows(const float* __restrict__ in, const float* __restrict__ g, const float* __restrict__ b,
                        float* __restrict__ of, u16* __restrict__ ob) {
    const int tid = opaque_tid(); const int lane = tid & 63, wave = tid >> 6;
    float4 gv[8], bv[8];
#pragma unroll
    for (int i = 0; i < 8; ++i) { gv[i] = *(const float4*)(g + i * 256 + lane * 4); bv[i] = *(const float4*)(b + i * 256 + lane * 4); }
    const int stride = gridDim.x * 4;
    int row = blockIdx.x * 4 + wave;
    float4 v[8];
    if (row < NTOK) {
#pragma unroll
        for (int i = 0; i < 8; ++i) v[i] = *(const float4*)(in + (size_t)row * DM + i * 256 + lane * 4);
    }
    for (; row < NTOK; row += stride) {
        float s = 0.f;
#pragma unroll
        for (int i = 0; i < 8; ++i) s += v[i].x + v[i].y + v[i].z + v[i].w;
        const float mu = wsum(s) * (1.f / DM);
        float q = 0.f;
#pragma unroll
        for (int i = 0; i < 8; ++i) {
            const float a = v[i].x - mu, bb = v[i].y - mu, c = v[i].z - mu, d = v[i].w - mu;
            q += a * a + bb * bb + c * c + d * d;
        }
        const float rs = rsqrtf(wsum(q) * (1.f / DM) + LN_EPS);
        float4 o[8];
#pragma unroll
        for (int i = 0; i < 8; ++i) {
            o[i].x = (v[i].x - mu) * rs * gv[i].x + bv[i].x; o[i].y = (v[i].y - mu) * rs * gv[i].y + bv[i].y;
            o[i].z = (v[i].z - mu) * rs * gv[i].z + bv[i].z; o[i].w = (v[i].w - mu) * rs * gv[i].w + bv[i].w;
        }
        const int nrow = row + stride;
        if (nrow < NTOK) {
#pragma unroll
            for (int i = 0; i < 8; ++i) v[i] = *(const float4*)(in + (size_t)nrow * DM + i * 256 + lane * 4);
        }
#pragma unroll
        for (int i = 0; i < 8; ++i) {
            const int c0 = i * 256 + lane * 4;
            *(float4*)(of + (size_t)row * DM + c0) = o[i];
            *(uint2*)(ob + (size_t)row * DM + c0) = make_uint2(pack2(o[i].x, o[i].y), pack2(o[i].z, o[i].w));
        }
    }
}

__device__ __forceinline__ void phase0(const Params& p, unsigned char* smem) {
    unsigned char* ws = p.ws;
    const int bid = blockIdx.x, nb = gridDim.x;
    cvt_job(p.x, (u16*)(ws + OFF_RC), (size_t)NTOK * DM, bid, nb);
    cvt_job(p.mem, (u16*)(ws + OFF_MEMB), (size_t)512 * DM, bid, nb);
    transpose_job(p.w_in, (u16*)(ws + OFF_WT_IN), 2048, 6144, smem, bid, nb);
    transpose_job(p.xa_wk, (u16*)(ws + OFF_WT_K), 2048, 2048, smem, bid, nb);
    transpose_job(p.xa_wv, (u16*)(ws + OFF_WT_V), 2048, 2048, smem, bid, nb);
}
__device__ __forceinline__ void phase0_deferred(const Params& p, unsigned char* smem, int bid, int nb) {
    unsigned char* ws = p.ws;
    cvt_job(p.xa_wq, (u16*)(ws + OFF_WQ_B), (size_t)DM * DM, bid, nb);
    cvt_job(p.peer_wq, (u16*)(ws + OFF_PWQ_B), (size_t)DM * DM, bid, nb);
    cvt_job(p.peer_k1, (u16*)(ws + OFF_K1B), (size_t)128 * 128, bid, nb);
    cvt_job(p.peer_k2, (u16*)(ws + OFF_K2B), (size_t)128 * 128, bid, nb);
    transpose_job(p.w_out, (u16*)(ws + OFF_WT_OUT), 2048, 2048, smem, bid, nb);
    transpose_job(p.xa_wo, (u16*)(ws + OFF_WT_O), 2048, 2048, smem, bid, nb);
}

__device__ __forceinline__ void phase1(const Params& p, unsigned char* smem, const int vbid) {
    unsigned char* ws = p.ws;
    const u16* xb = (const u16*)(ws + OFF_RC);
    FOR_TILES_XCD_BIG(48, m, n) {
        {
            const int seg = n >> 3;
            const int cb = (n & 7) * 128;
            const u16* A = xb + (size_t)m * 256 * DM;
            const u16* Bt = (const u16*)(ws + OFF_WT_IN) + (size_t)n * 128 * DM;
            const size_t rbase = (size_t)m * 256;
            if (seg == 3) {
                float* LF = (float*)(ws + OFF_LF);
                float* lbs = (float*)(smem + 73728);
                __syncthreads();
                {
                    const int t2 = opaque_tid();
                    if (t2 < 128) lbs[t2] = sigmoid_f(p.lb_logits[cb + t2] - p.lb_logits[1024 + cb + t2]);
                }
                gemm_tile_big(A, DM, Bt, DM, DM, smem, [&](int r, int c, f32x4 v) {
                    const f32x4 lb4 = *(const f32x4*)(lbs + c);
                    f32x4 o;
#pragma unroll
                    for (int q = 0; q < 4; ++q) o[q] = __logf(lb4[q] + (1.f - lb4[q]) * sigmoid_f(v[q]));
                    *(f32x4*)(LF + (rbase + r) * 1024 + cb + c) = o;
                });
            } else {
                u16* O = (u16*)(ws + (seg == 0 ? OFF_UA : seg == 1 ? OFF_VA : seg == 2 ? OFF_QB : seg == 4 ? OFF_IB : OFF_GB));
                if (seg <= 1) {
                    gemm_tile_big(A, DM, Bt, DM, DM, smem, [&](int r, int c, f32x4 v) { st_bf4(O + (rbase + r) * 1024 + cb + c, f32x4{gelu_t(v[0]), gelu_t(v[1]), gelu_t(v[2]), gelu_t(v[3])}); });
                } else if (seg == 5) {
                    gemm_tile_big(A, DM, Bt, DM, DM, smem, [&](int r, int c, f32x4 v) { st_bf4(O + (rbase + r) * 1024 + cb + c, f32x4{v[0] * sigmoid_f(v[0]), v[1] * sigmoid_f(v[1]), v[2] * sigmoid_f(v[2]), v[3] * sigmoid_f(v[3])}); });
                } else {
                    gemm_tile_big(A, DM, Bt, DM, DM, smem, [&](int r, int c, f32x4 v) { st_bf4(O + (rbase + r) * 1024 + cb + c, v); });
                }
            }
        }
    }
    if ((int)gridDim.x > 128) {
        if ((int)blockIdx.x >= 128) phase0_deferred(p, smem, (int)blockIdx.x - 128, (int)gridDim.x - 128);
    } else {
        phase0_deferred(p, smem, (int)blockIdx.x, (int)gridDim.x);
    }
    for (int idx = blockIdx.x; idx < 128; idx += gridDim.x) {
        {
            const int which = idx >> 6, m = (idx & 63) >> 4, n = idx & 15;
            const u16* A = (const u16*)(ws + OFF_MEMB) + (size_t)m * 128 * DM;
            const u16* Bt = (const u16*)(ws + (which ? OFF_WT_V : OFF_WT_K)) + (size_t)n * 128 * DM;
            u16* O = (u16*)(ws + (which ? OFF_VP : OFF_KP));
            gemm_tile(A, DM, Bt, DM, DM, smem, [&](int r, int c, f32x4 v) { st_bf4(O + (size_t)(m * 128 + r) * DM + n * 128 + c, v); });
        }
    }
}

__device__ __forceinline__ void sgu_item(const Params& p, int idx, unsigned char* smem) {
    unsigned char* ws = p.ws;
    const int b = idx >> 8, c = (idx >> 3) & 31, g = idx & 7;
    const size_t p0 = (size_t)b * SEQ + (size_t)c * 128;
    u16* sW = (u16*)smem;
    u16* sV = sW + 128 * 136;
    const int tid = opaque_tid(), lane = tid & 63, wave = tid >> 6;
    lds_barrier();
    const float* wg = p.sgu_w + (size_t)g * 128 * 128;
    f32x4 wv[16];
#pragma unroll
    for (int i = 0; i < 16; ++i) wv[i] = *(const f32x4*)(wg + (tid + 256 * i) * 4);
    const u16* VA = (const u16*)(ws + OFF_VA);
    const int ch0 = (tid & 15) * 8;
    float lg[8], lbv[8];
#pragma unroll
    for (int j = 0; j < 8; ++j) { lg[j] = p.sgu_ln_g[g * 128 + ch0 + j]; lbv[j] = p.sgu_ln_b[g * 128 + ch0 + j]; }
    u32x4 rawv[8];
#pragma unroll
    for (int ps = 0; ps < 8; ++ps) rawv[ps] = *(const u32x4*)(VA + (p0 + (tid >> 4) + 16 * ps) * 1024 + g * 128 + ch0);
#pragma unroll
    for (int i = 0; i < 16; ++i) {
        const int e = (tid + 256 * i) * 4;
        const int t = e >> 7, s = e & 127;
        const float4 v = make_float4(wv[i][0], wv[i][1], wv[i][2], wv[i][3]);
        const float a0 = (s + 0 <= t) ? v.x : 0.f, a1 = (s + 1 <= t) ? v.y : 0.f, a2 = (s + 2 <= t) ? v.z : 0.f, a3 = (s + 3 <= t) ? v.w : 0.f;
        *(uint2*)(sW + t * 136 + s) = make_uint2(pack2(a0, a1), pack2(a2, a3));
    }
#pragma unroll 2
    for (int ps = 0; ps < 8; ++ps) {
        const int s = (tid >> 4) + 16 * ps;
        const u32x4 raw = rawv[ps];
        float v[8];
        v[0] = bflo(raw[0]); v[1] = bfhi(raw[0]); v[2] = bflo(raw[1]); v[3] = bfhi(raw[1]);
        v[4] = bflo(raw[2]); v[5] = bfhi(raw[2]); v[6] = bflo(raw[3]); v[7] = bfhi(raw[3]);
        float sm = 0.f;
#pragma unroll
        for (int j = 0; j < 8; ++j) sm += v[j];
#pragma unroll
        for (int o = 8; o > 0; o >>= 1) sm += __shfl_xor(sm, o);
        const float mu = sm * (1.f / 128.f);
        float q = 0.f;
#pragma unroll
        for (int j = 0; j < 8; ++j) { v[j] -= mu; q += v[j] * v[j]; }
#pragma unroll
        for (int o = 8; o > 0; o >>= 1) q += __shfl_xor(q, o);
        const float rs = rsqrtf(q * (1.f / 128.f) + LN_EPS);
#pragma unroll
        for (int j = 0; j < 8; ++j) v[j] = v[j] * rs * lg[j] + lbv[j];
        *(uint4*)(sV + s * 128 + ch0) = make_uint4(pack2(v[0], v[1]), pack2(v[2], v[3]), pack2(v[4], v[5]), pack2(v[6], v[7]));
    }
    lds_barrier();
    const int wm = wave >> 1, wn = wave & 1;
    f32x16 acc[2][2];
#pragma unroll
    for (int i = 0; i < 2; ++i)
#pragma unroll
        for (int j = 0; j < 2; ++j)
#pragma unroll
            for (int r = 0; r < 16; ++r) acc[i][j][r] = 0.f;
    const int nks = (wm + 1) * 4;
    for (int ks = 0; ks < nks; ++ks) {
        bf16x8 af[2], bf[2];
#pragma unroll
        for (int i = 0; i < 2; ++i) af[i] = *(const bf16x8*)(sW + (wm * 64 + i * 32 + (lane & 31)) * 136 + ks * 16 + (lane >> 5) * 8);
#pragma unroll
        for (int j = 0; j < 2; ++j) bf[j] = ld_frag_strided(sV + (ks * 16 + (lane >> 5) * 8) * 128 + wn * 64 + j * 32 + (lane & 31), 128);
#pragma unroll
        for (int i = 0; i < 2; ++i)
#pragma unroll
            for (int j = 0; j < 2; ++j)
                acc[i][j] = __builtin_amdgcn_mfma_f32_32x32x16_bf16(bf[j], af[i], acc[i][j], 0, 0, 0);
    }
    const u16* UA = (const u16*)(ws + OFF_UA);
    u16* Y = (u16*)(ws + OFF_RC);
#pragma unroll
    for (int i = 0; i < 2; ++i) {
        const int t = wm * 64 + i * 32 + (lane & 31);
        const float bias = p.sgu_b[g * 128 + t];
        uint2 ur[2][4];
#pragma unroll
        for (int j = 0; j < 2; ++j)
#pragma unroll
            for (int gq = 0; gq < 4; ++gq) {
                const int d = wn * 64 + j * 32 + 8 * gq + 4 * (lane >> 5);
                ur[j][gq] = *(const uint2*)(UA + (p0 + t) * 1024 + g * 128 + d);
            }
#pragma unroll
        for (int j = 0; j < 2; ++j)
#pragma unroll
            for (int gq = 0; gq < 4; ++gq) {
                const int d = wn * 64 + j * 32 + 8 * gq + 4 * (lane >> 5);
                const f32x4 o = {bflo(ur[j][gq].x) * (acc[i][j][4 * gq] + bias), bfhi(ur[j][gq].x) * (acc[i][j][4 * gq + 1] + bias),
                                 bflo(ur[j][gq].y) * (acc[i][j][4 * gq + 2] + bias), bfhi(ur[j][gq].y) * (acc[i][j][4 * gq + 3] + bias)};
                st_bf4(Y + (p0 + t) * DM + g * 128 + d, o);
            }
    }
}

__device__ __forceinline__ void hgrn_a_item(const Params& p, int idx, unsigned char* smem) {
    unsigned char* ws = p.ws;
    const int b = idx >> 9, h = (idx >> 6) & 7, c = idx & 63;
    const size_t p0 = (size_t)b * SEQ + (size_t)c * 64;
    u16* sKL = (u16*)smem;
    u16* sI = sKL + 64 * 128;
    float* tot = (float*)(sI + 64 * 128);
    const int tid = opaque_tid(), lane = tid & 63, wave = tid >> 6;
    const int k = tid & 127, half = tid >> 7;
    lds_barrier();
    const float* LF = (const float*)(ws + OFF_LF) + (p0 + half * 32) * 1024 + h * 128 + k;
    float lfv[32];
    float run = 0.f;
#pragma unroll
    for (int s = 0; s < 32; ++s) { lfv[s] = LF[(size_t)s * 1024]; run += lfv[s]; }
    if (half == 0) tot[k] = run; else tot[128 + k] = run;
    const u16* IB = (const u16*)(ws + OFF_IB);
#pragma unroll
    for (int i = 0; i < 4; ++i) {
        const int cidx = tid + 256 * i;
        const int s = cidx >> 4, v8 = (cidx & 15) * 8;
        *(uint4*)(sI + s * 128 + v8) = *(const uint4*)(IB + (p0 + s) * 1024 + h * 128 + v8);
    }
    lds_barrier();
    const float t0 = tot[k];
    const float alast = t0 + tot[128 + k];
    float a = half ? t0 : 0.f;
#pragma unroll
    for (int s = 0; s < 32; ++s) {
        a += lfv[s];
        const float kl = (1.f - __expf(lfv[s])) * __expf(alast - a);
        sKL[(half * 32 + s) * 128 + k] = f2bf(kl);
    }
    if (half == 0) ((float*)(ws + OFF_DEC))[(size_t)idx * 128 + k] = __expf(alast);
    lds_barrier();
    const int wm = wave >> 1, wn = wave & 1;
    f32x16 acc[2][2];
#pragma unroll
    for (int i = 0; i < 2; ++i)
#pragma unroll
        for (int j = 0; j < 2; ++j)
#pragma unroll
            for (int r = 0; r < 16; ++r) acc[i][j][r] = 0.f;
#pragma unroll 1
    for (int ks = 0; ks < 4; ++ks) {
        bf16x8 af[2], bf[2];
        const int kr = (ks * 16 + (lane >> 5) * 8) * 128;
#pragma unroll
        for (int i = 0; i < 2; ++i) af[i] = ld_frag_strided(sI + kr + wm * 64 + i * 32 + (lane & 31), 128);
#pragma unroll
        for (int j = 0; j < 2; ++j) bf[j] = ld_frag_strided(sKL + kr + wn * 64 + j * 32 + (lane & 31), 128);
#pragma unroll
        for (int i = 0; i < 2; ++i)
#pragma unroll
            for (int j = 0; j < 2; ++j)
                acc[i][j] = __builtin_amdgcn_mfma_f32_32x32x16_bf16(bf[j], af[i], acc[i][j], 0, 0, 0);
    }
    float* UT = (float*)(ws + OFF_UT) + (size_t)idx * 16384;
#pragma unroll
    for (int i = 0; i < 2; ++i)
#pragma unroll
        for (int j = 0; j < 2; ++j)
#pragma unroll
            for (int g = 0; g < 4; ++g) {
                const int v = wm * 64 + i * 32 + (lane & 31);
                const int kk = wn * 64 + j * 32 + 8 * g + 4 * (lane >> 5);
                *(f32x4*)(UT + v * 128 + kk) = f32x4{acc[i][j][4 * g], acc[i][j][4 * g + 1], acc[i][j][4 * g + 2], acc[i][j][4 * g + 3]};
            }
}

__device__ __forceinline__ void phase2(const Params& p, unsigned char* smem) {
    unsigned char* ws = p.ws;
    const int NIT = 512 + 1024 + 256 + 256 + 256;
    for (int it = blockIdx.x; it < NIT; it += gridDim.x) {
        if (it < 1024) {
            hgrn_a_item(p, it, smem);
        } else if (it < 1536) {
            sgu_item(p, it - 1024, smem);
        } else if (it < 1792) {
            const int q = it - 1536;
            const int bh = q >> 5, mt = (q >> 4) & 1, nt = q & 15;
            const int b = bh >> 2, h = bh & 3;
            const u16* A = (const u16*)(ws + OFF_KP) + (size_t)(b * 256 + mt * 128) * DM + h * 512;
            const u16* Bt = (const u16*)(ws + OFF_WQ_B) + (size_t)(nt * 128) * DM + h * 512;
            u16* O = (u16*)(ws + OFF_WQKT) + (size_t)b * 1024 * DM + (size_t)(h * 256 + mt * 128) * DM + nt * 128;
            gemm_tile(A, DM, Bt, DM, 512, smem, [&](int r, int c, f32x4 v) { st_bf4(O + (size_t)r * DM + c, v * 0.04419417382415922f); });
        } else if (it < 2048) {
            const int q = it - 1792;
            const int bh = q >> 5, mt = (q >> 1) & 15, nt = q & 1;
            const int b = bh >> 2, h = bh & 3;
            const u16* A = (const u16*)(ws + OFF_WT_O) + (size_t)(mt * 128) * DM + h * 512;
            const u16* Bt = (const u16*)(ws + OFF_VP) + (size_t)(b * 256 + nt * 128) * DM + h * 512;
            u16* O = (u16*)(ws + OFF_WVOT) + (size_t)b * 2048 * 1024 + (size_t)(mt * 128) * 1024 + h * 256 + nt * 128;
            gemm_tile(A, DM, Bt, DM, 512, smem, [&](int r, int c, f32x4 v) { st_bf4(O + (size_t)r * 1024 + c, v); });
        } else {
            const int q = it - 2048;
            const int hp = q >> 4, nt = q & 15;
            const u16* A = (const u16*)(ws + ((hp & 1) ? OFF_K2B : OFF_K1B));
            const u16* Bt = (const u16*)(ws + OFF_PWQ_B) + (size_t)(nt * 128) * DM + hp * 128;
            u16* O = (u16*)(ws + OFF_WSKT) + (size_t)(hp * 128) * DM + nt * 128;
            gemm_tile(A, 128, Bt, DM, 128, smem, [&](int r, int c, f32x4 v) { st_bf4(O + (size_t)r * DM + c, v); });
        }
    }
}

__device__ __forceinline__ void phase3(const Params& p) {
    unsigned char* ws = p.ws;
    const float* UT = (const float*)(ws + OFF_UT);
    const float* DEC = (const float*)(ws + OFF_DEC);
    u16* ST = (u16*)(ws + OFF_ST);
    const int tid = opaque_tid();
    const int nth = gridDim.x * 256;
    for (int e0 = blockIdx.x * 256 + tid; e0 < 8 * 16384; e0 += nth) {
        const int bh0 = e0 >> 14, vk = e0 & 16383, k = vk & 127, bh1 = bh0 + 8;
        float S0 = 0.f, S1 = 0.f;
        const float* up0 = UT + (size_t)bh0 * 64 * 16384 + vk;
        const float* up1 = UT + (size_t)bh1 * 64 * 16384 + vk;
        const float* dp0 = DEC + (size_t)bh0 * 64 * 128 + k;
        const float* dp1 = DEC + (size_t)bh1 * 64 * 128 + k;
        u16* sp0 = ST + (size_t)bh0 * 64 * 16384 + vk;
        u16* sp1 = ST + (size_t)bh1 * 64 * 16384 + vk;
#pragma unroll 1
        for (int cb = 0; cb < 64; cb += 16) {
            float u0[16], u1[16], d0[16], d1[16];
#pragma unroll
            for (int c = 0; c < 16; ++c) {
                u0[c] = up0[(size_t)(cb + c) * 16384]; u1[c] = up1[(size_t)(cb + c) * 16384];
                d0[c] = dp0[(cb + c) * 128]; d1[c] = dp1[(cb + c) * 128];
            }
#pragma unroll
            for (int c = 0; c < 16; ++c) {
                sp0[(size_t)(cb + c) * 16384] = f2bf(S0);
                sp1[(size_t)(cb + c) * 16384] = f2bf(S1);
                S0 = d0[c] * S0 + u0[c];
                S1 = d1[c] * S1 + u1[c];
            }
        }
    }
}

__device__ __forceinline__ void hgrn_c_item(const Params& p, int idx, unsigned char* smem) {
    unsigned char* ws = p.ws;
    const int b = idx >> 9, h = (idx >> 6) & 7, c = idx & 63;
    const size_t p0 = (size_t)b * SEQ + (size_t)c * 64;
    u16* sQE = (u16*)smem;
    u16* sKE = sQE + 64 * 136;
    u16* sI = sKE + 64 * 136;
    u16* sP = sI + 64 * 128;
    float* tot = (float*)(sP + 64 * 72);
    float* sO = (float*)smem;
    const int tid = opaque_tid(), lane = tid & 63, wave = tid >> 6;
    const int k = tid & 127, half = tid >> 7;
    lds_barrier();
    const float* LF = (const float*)(ws + OFF_LF) + (p0 + half * 32) * 1024 + h * 128 + k;
    float lfv[32];
    float run = 0.f;
#pragma unroll
    for (int s = 0; s < 32; ++s) { lfv[s] = LF[(size_t)s * 1024]; run += lfv[s]; }
    if (half == 0) tot[k] = run;
    const u16* QB = (const u16*)(ws + OFF_QB) + (p0 + half * 32) * 1024 + h * 128 + k;
    u16 qv[32];
#pragma unroll
    for (int s = 0; s < 32; ++s) qv[s] = QB[(size_t)s * 1024];
    const u16* IB = (const u16*)(ws + OFF_IB);
    u32x4 ibv[4];
#pragma unroll
    for (int i = 0; i < 4; ++i) {
        const int cidx = tid + 256 * i;
        ibv[i] = *(const u32x4*)(IB + (p0 + (cidx >> 4)) * 1024 + h * 128 + (cidx & 15) * 8);
    }
    bf16x8 stf[8][2];
    {
        const u16* STp = (const u16*)(ws + OFF_ST) + (size_t)idx * 16384;
        const int vn_ = wave & 1;
#pragma unroll
        for (int ks = 0; ks < 8; ++ks)
#pragma unroll
            for (int j = 0; j < 2; ++j)
                stf[ks][j] = *(const bf16x8*)(STp + (vn_ * 64 + j * 32 + (lane & 31)) * 128 + ks * 16 + (lane >> 5) * 8);
    }
#pragma unroll
    for (int i = 0; i < 4; ++i) {
        const int cidx = tid + 256 * i;
        *(u32x4*)(sI + (cidx >> 4) * 128 + (cidx & 15) * 8) = ibv[i];
    }
    lds_barrier();
    float a = half ? tot[k] : 0.f;
#pragma unroll
    for (int s = 0; s < 32; ++s) {
        a += lfv[s];
        const float q = bf2f(qv[s]);
        const int t = half * 32 + s;
        sQE[t * 136 + k] = f2bf(q * __expf(a));
        sKE[t * 136 + k] = f2bf((1.f - __expf(lfv[s])) * __expf(fminf(-a, 80.f)));
    }
    lds_barrier();
    {
        const int tm = wave >> 1, sn = wave & 1;
        f32x16 sc;
#pragma unroll
        for (int r = 0; r < 16; ++r) sc[r] = 0.f;
        if (sn <= tm) {
#pragma unroll
            for (int ks = 0; ks < 8; ++ks) {
                const bf16x8 af = *(const bf16x8*)(sQE + (tm * 32 + (lane & 31)) * 136 + ks * 16 + (lane >> 5) * 8);
                const bf16x8 bf = *(const bf16x8*)(sKE + (sn * 32 + (lane & 31)) * 136 + ks * 16 + (lane >> 5) * 8);
                sc = __builtin_amdgcn_mfma_f32_32x32x16_bf16(af, bf, sc, 0, 0, 0);
            }
        }
#pragma unroll
        for (int r = 0; r < 16; ++r) {
            const int t = tm * 32 + (r & 3) + 8 * (r >> 2) + 4 * (lane >> 5);
            const int s = sn * 32 + (lane & 31);
            const float v = (s <= t) ? sc[r] : 0.f;
            sP[t * 72 + s] = f2bf(v);
        }
    }
    lds_barrier();
    const int tm = wave >> 1, vn = wave & 1;
    f32x16 acc[2];
#pragma unroll
    for (int j = 0; j < 2; ++j)
#pragma unroll
        for (int r = 0; r < 16; ++r) acc[j][r] = 0.f;
    {
        const int nks = (tm + 1) * 2;
        for (int ks = 0; ks < nks; ++ks) {
            const bf16x8 af = *(const bf16x8*)(sP + (tm * 32 + (lane & 31)) * 72 + ks * 16 + (lane >> 5) * 8);
#pragma unroll
            for (int j = 0; j < 2; ++j) {
                const bf16x8 bf = ld_frag_strided(sI + (ks * 16 + (lane >> 5) * 8) * 128 + vn * 64 + j * 32 + (lane & 31), 128);
                acc[j] = __builtin_amdgcn_mfma_f32_32x32x16_bf16(af, bf, acc[j], 0, 0, 0);
            }
        }
#pragma unroll
        for (int ks = 0; ks < 8; ++ks) {
            const bf16x8 af = *(const bf16x8*)(sQE + (tm * 32 + (lane & 31)) * 136 + ks * 16 + (lane >> 5) * 8);
#pragma unroll
            for (int j = 0; j < 2; ++j) acc[j] = __builtin_amdgcn_mfma_f32_32x32x16_bf16(af, stf[ks][j], acc[j], 0, 0, 0);
        }
    }
    lds_barrier();
#pragma unroll
    for (int j = 0; j < 2; ++j)
#pragma unroll
        for (int r = 0; r < 16; ++r) {
            const int t = tm * 32 + (r & 3) + 8 * (r >> 2) + 4 * (lane >> 5);
            const int v = vn * 64 + j * 32 + (lane & 31);
            sO[t * 132 + v] = acc[j][r];
        }
    lds_barrier();
    {
        const int t = tid >> 2, q = tid & 3;
        float o[32];
        float ss = 0.f;
#pragma unroll
        for (int i = 0; i < 4; ++i) {
            const float4 a = *(const float4*)(sO + t * 132 + (i * 4 + q) * 8), bq = *(const float4*)(sO + t * 132 + (i * 4 + q) * 8 + 4);
            o[i * 8 + 0] = a.x; o[i * 8 + 1] = a.y; o[i * 8 + 2] = a.z; o[i * 8 + 3] = a.w;
            o[i * 8 + 4] = bq.x; o[i * 8 + 5] = bq.y; o[i * 8 + 6] = bq.z; o[i * 8 + 7] = bq.w;
        }
#pragma unroll
        for (int i = 0; i < 32; ++i) ss += o[i] * o[i];
        ss += __shfl_xor(ss, 1);
        ss += __shfl_xor(ss, 2);
        const float rs = rsqrtf(ss * (1.f / 128.f) + LN_EPS);
        const u16* GB = (const u16*)(ws + OFF_GB) + (p0 + t) * 1024 + h * 128;
        u16* Y = (u16*)(ws + OFF_RC) + (p0 + t) * DM + 1024 + h * 128;
        const float* gn = p.hgrn_g + h * 128;
        u32x4 gr[4];
        f32x4 gnv[4][2];
#pragma unroll
        for (int i = 0; i < 4; ++i) {
            gr[i] = *(const u32x4*)(GB + (i * 4 + q) * 8);
            gnv[i][0] = *(const f32x4*)(gn + (i * 4 + q) * 8); gnv[i][1] = *(const f32x4*)(gn + (i * 4 + q) * 8 + 4);
        }
#pragma unroll
        for (int i = 0; i < 4; ++i) {
            const int v0 = (i * 4 + q) * 8;
            const float4 g0 = make_float4(gnv[i][0][0], gnv[i][0][1], gnv[i][0][2], gnv[i][0][3]);
            const float4 g1 = make_float4(gnv[i][1][0], gnv[i][1][1], gnv[i][1][2], gnv[i][1][3]);
            u32x4 w;
            w[0] = pack2(o[i * 8 + 0] * rs * g0.x * bflo(gr[i][0]), o[i * 8 + 1] * rs * g0.y * bfhi(gr[i][0]));
            w[1] = pack2(o[i * 8 + 2] * rs * g0.z * bflo(gr[i][1]), o[i * 8 + 3] * rs * g0.w * bfhi(gr[i][1]));
            w[2] = pack2(o[i * 8 + 4] * rs * g1.x * bflo(gr[i][2]), o[i * 8 + 5] * rs * g1.y * bfhi(gr[i][2]));
            w[3] = pack2(o[i * 8 + 6] * rs * g1.z * bflo(gr[i][3]), o[i * 8 + 7] * rs * g1.w * bfhi(gr[i][3]));
            *(u32x4*)(Y + v0) = w;
        }
    }
}

__device__ __forceinline__ void phase8(const Params& p) {
    unsigned char* ws = p.ws;
    const float* SC = (const float*)(ws + OFF_SC);
    u16* PB = (u16*)(ws + OFF_PB);
    const int tid = opaque_tid(); const int lane = tid & 63, wave = tid >> 6;
    const int stride = gridDim.x * 4;
    int row = blockIdx.x * 4 + wave;
    f32x4 tv4[4];
    if (row < NTOK) {
#pragma unroll
        for (int i = 0; i < 4; ++i) tv4[i] = *(const f32x4*)(SC + (size_t)row * 1024 + lane * 16 + i * 4);
    }
    for (; row < NTOK; row += stride) {
        float v[16];
#pragma unroll
        for (int i = 0; i < 4; ++i) { v[4 * i] = tv4[i][0]; v[4 * i + 1] = tv4[i][1]; v[4 * i + 2] = tv4[i][2]; v[4 * i + 3] = tv4[i][3]; }
        const int nrow = row + stride;
        if (nrow < NTOK) {
#pragma unroll
            for (int i = 0; i < 4; ++i) tv4[i] = *(const f32x4*)(SC + (size_t)nrow * 1024 + lane * 16 + i * 4);
        }
        float m = v[0];
#pragma unroll
        for (int i = 1; i < 16; ++i) m = fmaxf(m, v[i]);
#pragma unroll
        for (int o = 8; o > 0; o >>= 1) m = fmaxf(m, __shfl_xor(m, o));
        float s = 0.f;
#pragma unroll
        for (int i = 0; i < 16; ++i) { v[i] = __expf(v[i] - m); s += v[i]; }
#pragma unroll
        for (int o = 8; o > 0; o >>= 1) s += __shfl_xor(s, o);
        const float inv = 1.f / s;
        uint32_t o[8];
#pragma unroll
        for (int i = 0; i < 8; ++i) o[i] = pack2(v[2 * i] * inv, v[2 * i + 1] * inv);
        u32x4* dp = (u32x4*)(PB + (size_t)row * 1024 + lane * 16);
        dp[0] = u32x4{o[0], o[1], o[2], o[3]};
        dp[1] = u32x4{o[4], o[5], o[6], o[7]};
    }
}

__device__ __forceinline__ void phase12(const Params& p, unsigned char* smem) {
    unsigned char* ws = p.ws;
    const float* PS = (const float*)(ws + OFF_RD);
    const float* X2 = (const float*)(ws + OFF_RE);
    const unsigned char* UB = ws + OFF_UB;
    const unsigned char* VB = ws + OFF_VB;
    const float* SU = (const float*)(ws + OFF_SU);
    const float* SV = (const float*)(ws + OFF_SV);
    float* part = (float*)smem;
    float* sv = part + 4 * 2048;
    float* tv = sv + 4 * 128;
    int* ti = (int*)(tv + 256);
    float* selv = (float*)(ti + 256);
    int* sele = (int*)(selv + 128);
    float* gate = (float*)(sele + 128);
    float* red = gate + 128;
    const int tid = opaque_tid(), lane = tid & 63, wave = tid >> 6;
    int ci = 0, cj = 0;
    {
        int start = 0;
#pragma unroll
        for (int ii = 0; ii < 16; ++ii) {
            const int cnt = 16 / (ii + 1);
            if (lane >= start && lane < start + cnt) { ci = ii; cj = lane - start; }
            start += cnt;
        }
    }
    const float NEG_INF = -__builtin_huge_valf();
    const f32x4 l3g0 = *(const f32x4*)(p.ln3_g + tid * 8), l3g1 = *(const f32x4*)(p.ln3_g + tid * 8 + 4);
    const f32x4 l3b0 = *(const f32x4*)(p.ln3_b + tid * 8), l3b1 = *(const f32x4*)(p.ln3_b + tid * 8 + 4);
    int* nxt = (int*)(red + 8);
    unsigned* tok_ctr = (unsigned*)(ws + OFF_BAR) + 3600;
    if (tid == 0) nxt[0] = (int)__hip_atomic_fetch_add(tok_ctr, 1u, __ATOMIC_RELAXED, __HIP_MEMORY_SCOPE_AGENT);
    lds_barrier();
    int tok = nxt[0];
    for (int it = 0; tok < NTOK; ++it) {
        lds_barrier();
        if (tid == 0) nxt[(it + 1) & 1] = (int)__hip_atomic_fetch_add(tok_ctr, 1u, __ATOMIC_RELAXED, __HIP_MEMORY_SCOPE_AGENT);
        float* svw = sv + wave * 128;
        unsigned* svk = (unsigned*)svw;
        float pv0[4], pv1[4];
#pragma unroll
        for (int gi = 0; gi < 4; ++gi) {
            const float* src = PS + (size_t)tok * DM + (wave * 4 + gi) * 128;
            pv0[gi] = src[lane]; pv1[gi] = src[lane + 64];
        }
        const float* xrow = X2 + (size_t)tok * DM;
        f32x4 xq[8];
#pragma unroll
        for (int q = 0; q < 2; ++q)
#pragma unroll
            for (int i = 0; i < 4; ++i) xq[q * 4 + i] = *(const f32x4*)(xrow + q * 1024 + lane * 16 + i * 4);
        const f32x4 xres0 = *(const f32x4*)(xrow + tid * 8), xres1 = *(const f32x4*)(xrow + tid * 8 + 4);
#pragma unroll
        for (int gi = 0; gi < 4; ++gi) {
            const int g = wave * 4 + gi;
            const float v0 = pv0[gi], v1 = pv1[gi];
            const unsigned k0 = (sort_key(v0) & ~127u) | (unsigned)(127 - lane);
            const unsigned k1 = (sort_key(v1) & ~127u) | (unsigned)(63 - lane);
            svk[lane] = k0; svk[lane + 64] = k1;
            int r0 = 0, r1 = 0;
#pragma unroll 8
            for (int j4 = 0; j4 < 32; ++j4) {
                const u32x4 q = ((const u32x4*)svk)[j4];
#pragma unroll
                for (int cc = 0; cc < 4; ++cc) {
                    asm("v_cmp_gt_u32 vcc, %1, %2\n\tv_addc_co_u32 %0, vcc, 0, %0, vcc" : "+v"(r0) : "v"(q[cc]), "v"(k0) : "vcc");
                    asm("v_cmp_gt_u32 vcc, %1, %2\n\tv_addc_co_u32 %0, vcc, 0, %0, vcc" : "+v"(r1) : "v"(q[cc]), "v"(k1) : "vcc");
                }
            }
            if (r0 < 16) { tv[g * 16 + r0] = v0; ti[g * 16 + r0] = lane; }
            if (r1 < 16) { tv[g * 16 + r1] = v1; ti[g * 16 + r1] = lane + 64; }
        }
        lds_barrier();
        for (int hi = 0; hi < 2; ++hi) {
            const int h = wave * 2 + hi;
            float cv = NEG_INF; int ce = 0;
            if (lane < 50) {
                cv = tv[(h * 2) * 16 + ci] + tv[(h * 2 + 1) * 16 + cj];
                ce = ti[(h * 2) * 16 + ci] * 128 + ti[(h * 2 + 1) * 16 + cj];
            }
            const unsigned ck = (sort_key(cv) & ~63u) | (unsigned)(63 - lane);
            svk[lane] = ck;
            int rk = 0;
#pragma unroll
            for (int j4 = 0; j4 < 16; ++j4) {
                const u32x4 q = ((const u32x4*)svk)[j4];
#pragma unroll
                for (int cc = 0; cc < 4; ++cc) asm("v_cmp_gt_u32 vcc, %1, %2\n\tv_addc_co_u32 %0, vcc, 0, %0, vcc" : "+v"(rk) : "v"(q[cc]), "v"(ck) : "vcc");
            }
            if (rk < 16) { selv[h * 16 + rk] = cv; sele[h * 16 + rk] = ce; }
            const float mv = selv[h * 16];
            float ev = 0.f;
            if (lane < 16) ev = __expf(selv[h * 16 + lane] - mv);
            float sm = ev;
#pragma unroll
            for (int o = 8; o > 0; o >>= 1) sm += __shfl_xor(sm, o);
            if (lane < 16) gate[h * 16 + lane] = ev / sm;
        }
        lds_barrier();
        f32x2 xr[16];
#pragma unroll
        for (int q = 0; q < 2; ++q)
#pragma unroll
            for (int i = 0; i < 4; ++i) {
                const f32x4 a = xq[q * 4 + i];
                xr[q * 8 + i * 2 + 0] = f32x2{a[0], a[1]}; xr[q * 8 + i * 2 + 1] = f32x2{a[2], a[3]};
            }
        f32x2 acc[16];
#pragma unroll
        for (int i = 0; i < 16; ++i) acc[i] = f32x2{0.f, 0.f};
#pragma unroll 1
        for (int i0 = 0; i0 < 32; i0 += 4) {
            u32x4 ru[4][2];
            u32x4 rv[4][2];
            int e[4];
            float su[4], sv4[4];
#pragma unroll
            for (int u = 0; u < 4; ++u) {
                e[u] = sele[wave * 32 + i0 + u];
                su[u] = SU[e[u]]; sv4[u] = SV[e[u]];
            }
#pragma unroll
            for (int u = 0; u < 4; ++u) {
                const unsigned char* rowp = UB + (size_t)e[u] * DM + lane * 16;
#pragma unroll
                for (int q = 0; q < 2; ++q) ru[u][q] = *(const u32x4*)(rowp + q * 1024);
            }
#pragma unroll
            for (int u = 0; u < 4; ++u) {
                const unsigned char* rowp = VB + (size_t)e[u] * DM + lane * 16;
#pragma unroll
                for (int q = 0; q < 2; ++q) rv[u][q] = *(const u32x4*)(rowp + q * 1024);
            }
            float d[4];
#pragma unroll
            for (int u = 0; u < 4; ++u) {
                f32x2 d2 = f32x2{0.f, 0.f};
#pragma unroll
                for (int q = 0; q < 2; ++q)
#pragma unroll
                    for (int i = 0; i < 4; ++i) {
                        const int w = (int)ru[u][q][i];
                        const f32x2 lo = __builtin_amdgcn_cvt_pk_f32_fp8(w, false);
                        const f32x2 hi = __builtin_amdgcn_cvt_pk_f32_fp8(w, true);
                        d2 = xr[q * 8 + i * 2 + 0] * lo + d2;
                        d2 = xr[q * 8 + i * 2 + 1] * hi + d2;
                    }
                d[u] = d2[0] + d2[1];
            }
            const bool up = (lane & 32) != 0;
            const float s0 = up ? d[0] : d[2], s1 = up ? d[1] : d[3];
            const float k0 = (up ? d[2] : d[0]) + __shfl_xor(s0, 32);
            const float k1 = (up ? d[3] : d[1]) + __shfl_xor(s1, 32);
            const bool up2 = (lane & 16) != 0;
            float val = (up2 ? k1 : k0) + __shfl_xor(up2 ? k0 : k1, 16);
#pragma unroll
            for (int o = 8; o > 0; o >>= 1) val += __shfl_xor(val, o);
            float wgt[4];
#pragma unroll
            for (int u = 0; u < 4; ++u) {
                const float tot = __uint_as_float(__builtin_amdgcn_readlane(__float_as_uint(val), u * 16)) * su[u];
                wgt[u] = gate[wave * 32 + i0 + u] * gelu_t(tot) * sv4[u];
            }
#pragma unroll
            for (int u = 0; u < 4; ++u) {
                const f32x2 w2 = f32x2{wgt[u], wgt[u]};
#pragma unroll
                for (int q = 0; q < 2; ++q)
#pragma unroll
                    for (int i = 0; i < 4; ++i) {
                        const int w = (int)rv[u][q][i];
                        const f32x2 lo = __builtin_amdgcn_cvt_pk_f32_fp8(w, false);
                        const f32x2 hi = __builtin_amdgcn_cvt_pk_f32_fp8(w, true);
                        acc[q * 8 + i * 2 + 0] = w2 * lo + acc[q * 8 + i * 2 + 0];
                        acc[q * 8 + i * 2 + 1] = w2 * hi + acc[q * 8 + i * 2 + 1];
                    }
            }
        }
#pragma unroll
        for (int q = 0; q < 2; ++q)
#pragma unroll
            for (int i = 0; i < 4; ++i) {
                float* pp = part + wave * 2048 + q * 1024 + lane * 16 + i * 4;
                *(float4*)(pp) = make_float4(acc[q * 8 + i * 2][0], acc[q * 8 + i * 2][1], acc[q * 8 + i * 2 + 1][0], acc[q * 8 + i * 2 + 1][1]);
            }
        lds_barrier();
        float rr[8];
        {
            rr[0] = DN_ALPHA * xres0[0]; rr[1] = DN_ALPHA * xres0[1]; rr[2] = DN_ALPHA * xres0[2]; rr[3] = DN_ALPHA * xres0[3];
            rr[4] = DN_ALPHA * xres1[0]; rr[5] = DN_ALPHA * xres1[1]; rr[6] = DN_ALPHA * xres1[2]; rr[7] = DN_ALPHA * xres1[3];
#pragma unroll
            for (int w = 0; w < 4; ++w) {
                const float4 a = *(const float4*)(part + w * 2048 + tid * 8), bq = *(const float4*)(part + w * 2048 + tid * 8 + 4);
                rr[0] += a.x; rr[1] += a.y; rr[2] += a.z; rr[3] += a.w; rr[4] += bq.x; rr[5] += bq.y; rr[6] += bq.z; rr[7] += bq.w;
            }
        }
        float s = 0.f;
#pragma unroll
        for (int j = 0; j < 8; ++j) s += rr[j];
        s = wsum(s);
        if (lane == 0) red[wave] = s;
        lds_barrier();
        const float mu = (red[0] + red[1] + red[2] + red[3]) * (1.f / DM);
        float qv = 0.f;
#pragma unroll
        for (int j = 0; j < 8; ++j) { rr[j] -= mu; qv += rr[j] * rr[j]; }
        qv = wsum(qv);
        if (lane == 0) red[4 + wave] = qv;
        lds_barrier();
        const float rs = rsqrtf((red[4] + red[5] + red[6] + red[7]) * (1.f / DM) + LN_EPS);
        float* op = p.out + (size_t)tok * DM + tid * 8;
        *(float4*)(op) = make_float4(rr[0] * rs * l3g0[0] + l3b0[0], rr[1] * rs * l3g0[1] + l3b0[1], rr[2] * rs * l3g0[2] + l3b0[2], rr[3] * rs * l3g0[3] + l3b0[3]);
        *(float4*)(op + 4) = make_float4(rr[4] * rs * l3g1[0] + l3b1[0], rr[5] * rs * l3g1[1] + l3b1[1], rr[6] * rs * l3g1[2] + l3b1[2], rr[7] * rs * l3g1[3] + l3b1[3]);
        tok = nxt[(it + 1) & 1];
    }
}

__device__ __forceinline__ void run_phase(int ph, const Params& p, unsigned char* smem, const int vbid) {
    unsigned char* ws = p.ws;
    switch (ph) {
    case 0: phase0(p, smem); break;
    case 1: phase1(p, smem, vbid); break;
    case 2: phase2(p, smem); break;
    case 3: phase3(p); break;
    case 4:
        for (int it = blockIdx.x; it < 1024; it += gridDim.x) hgrn_c_item(p, it, smem);
        break;
    case 5: {
        float* R1 = (float*)(ws + OFF_RD);
        FOR_TILES_XCD_BIG(16, m, n) {
            const int tile = m * 16 + n;
            const u16* A = (const u16*)(ws + OFF_RC) + (size_t)m * 256 * DM;
            const u16* Bt = (const u16*)(ws + OFF_WT_OUT) + (size_t)n * 128 * DM;
            const float* xr = p.x + (size_t)m * 256 * DM + n * 128;
            float* o = R1 + (size_t)m * 256 * DM + n * 128;
            gemm_tile_big(A, DM, Bt, DM, DM, smem, [&](int r, int c, f32x4 v) { *(f32x4*)(o + (size_t)r * DM + c) = v; }, xr, DM, DN_ALPHA);
            cvt_fp8_rows(p.peer_u, ws + OFF_UB, (float*)(ws + OFF_SU), tile * 32, tile * 32 + 32);
        }
    } break;
    case 6:
        ln_rows((const float*)(ws + OFF_RD), p.ln1_g, p.ln1_b, (float*)(ws + OFF_RE), (u16*)(ws + OFF_RC));
        break;
    case 7: {
        float* SC = (float*)(ws + OFF_SC);
        FOR_TILES_XCD(8, m, n) {
            const int b = m >> 5;
            const u16* A = (const u16*)(ws + OFF_RC) + (size_t)m * 128 * DM;
            const u16* Bt = (const u16*)(ws + OFF_WQKT) + (size_t)b * 1024 * DM + (size_t)n * 128 * DM;
            float* o = SC + (size_t)m * 128 * 1024 + n * 128;
            gemm_tile(A, DM, Bt, DM, DM, smem, [&](int r, int c, f32x4 v) { *(f32x4*)(o + (size_t)r * 1024 + c) = v; });
        }
    } break;
    case 8:
        phase8(p);
        break;
    case 9: {
        float* R2 = (float*)(ws + OFF_RD);
        const float* X1 = (const float*)(ws + OFF_RE);
        FOR_TILES_XCD_BIG(16, m, n) {
            const int tile = m * 16 + n;
            const int b = m >> 4;
            const u16* A = (const u16*)(ws + OFF_PB) + (size_t)m * 256 * 1024;
            const u16* Bt = (const u16*)(ws + OFF_WVOT) + (size_t)b * 2048 * 1024 + (size_t)n * 128 * 1024;
            const float* xr = X1 + (size_t)m * 256 * DM + n * 128;
            float* o = R2 + (size_t)m * 256 * DM + n * 128;
            gemm_tile_big(A, 1024, Bt, 1024, 1024, smem, [&](int r, int c, f32x4 v) { *(f32x4*)(o + (size_t)r * DM + c) = v; }, xr, DM, DN_ALPHA);
            cvt_fp8_rows(p.peer_v, ws + OFF_VB, (float*)(ws + OFF_SV), tile * 32, tile * 32 + 32);
        }
    } break;
    case 10:
        ln_rows((const float*)(ws + OFF_RD), p.ln2_g, p.ln2_b, (float*)(ws + OFF_RE), (u16*)(ws + OFF_RC));
        break;
    case 11: {
        float* PS = (float*)(ws + OFF_RD);
        FOR_TILES_XCD_BIG(16, m, n) {
            const u16* A = (const u16*)(ws + OFF_RC) + (size_t)m * 256 * DM;
            const u16* Bt = (const u16*)(ws + OFF_WSKT) + (size_t)n * 128 * DM;
            float* o = PS + (size_t)m * 256 * DM + n * 128;
            gemm_tile_big(A, DM, Bt, DM, DM, smem, [&](int r, int c, f32x4 v) { *(f32x4*)(o + (size_t)r * DM + c) = v; });
        }
    } break;
    case 12: phase12(p, smem); break;
    default: break;
    }
}

__global__ void __launch_bounds__(256, 2) fwd_kernel(Params p) {
    __shared__ __attribute__((aligned(16))) unsigned char smem_raw[SMEM_BYTES + 16];
    unsigned char* smem = smem_raw + 16;
    const bool multi = (p.ph_hi - p.ph_lo) > 1;
    XcdBarrier bar;
    if (multi) {
        if (threadIdx.x == 0) *(uint4*)smem_raw = make_uint4(0u, 0u, 0u, 0u);
        __syncthreads();
        bar = xcd_barrier_post((unsigned*)(p.ws + OFF_BAR), (volatile LAS unsigned*)smem_raw);
    }
    int vbid = blockIdx.x;
    for (int ph = p.ph_lo; ph < p.ph_hi; ++ph) {
        run_phase(ph, p, smem, vbid);
        if (ph + 1 < p.ph_hi) {
            xcd_barrier(bar);
            if (ph == p.ph_lo) {
                if (threadIdx.x == 0) {
                    unsigned* bw = (unsigned*)(p.ws + OFF_BAR);
                    const unsigned per = gridDim.x >> 3;
                    bool ok = (gridDim.x & 7u) == 0u;
                    for (unsigned j = 0; j < 16; ++j) { const unsigned c = xb_ld(&bw[XB_XCNT(j)]); ok = ok && (c == (j < 8 ? per : 0u)); }
                    const unsigned tk = bar.st[2];
                    bar.st[3] = (ok && tk < per && bar.x < 8u) ? (tk * 8u + bar.x) : blockIdx.x;
                }
                __syncthreads();
                vbid = (int)bar.st[3];
                __syncthreads();
            }
        }
    }
}

extern "C" void kernel_launch(void* const* d_in, const int* in_sizes, int n_in, void* d_out, int out_size,
                              void* d_ws, size_t ws_size, hipStream_t stream) {
    static int grid = 0;
    if (grid == 0) {
        if (n_in != 25 || ws_size < OFF_END) { fprintf(stderr, "kernel_launch: unexpected n_in %d or ws_size %zu (< %zu)\n", n_in, ws_size, (size_t)OFF_END); grid = -1; return; }
        int dev = 0, cus = 0, per_cu = 0;
        hipGetDevice(&dev);
        hipDeviceGetAttribute(&cus, hipDeviceAttributeMultiprocessorCount, dev);
        hipOccupancyMaxActiveBlocksPerMultiprocessor(&per_cu, (const void*)fwd_kernel, 256, 0);
        if (per_cu > 2) per_cu = 2;
        if (per_cu < 1) per_cu = 1;
        grid = cus * per_cu;
    }
    if (grid < 0) return;
    Params p{};
    const float** pp = (const float**)&p;
    for (int i = 0; i < 25; ++i) pp[i] = (const float*)d_in[i];
    p.out = (float*)d_out;
    p.ws = (unsigned char*)d_ws;
#if ONE_LAUNCH
    hipMemsetAsync((unsigned char*)d_ws + OFF_BAR, 0, 16384, stream);
    p.ph_lo = 0; p.ph_hi = NPHASE;
    void* args[] = {&p};
    hipError_t e = hipLaunchCooperativeKernel((const void*)fwd_kernel, dim3(grid), dim3(256), args, 0, stream);
    if (e != hipSuccess) fprintf(stderr, "cooperative launch failed: %s (grid %d)\n", hipGetErrorString(e), grid);
#else
    for (int ph = 0; ph < NPHASE; ++ph) {
        p.ph_lo = ph; p.ph_hi = ph + 1;
        hipLaunchKernelGGL(fwd_kernel, dim3(grid), dim3(256), 0, stream, p);
    }
#endif
}
```
